# Optimizing an MI355X kernel written in HIP

```python
import math
import jax, jax.numpy as jnp
from jax import lax
import numpy as np

D_MODEL = 1024
BATCH = 4
SEQ = 8192
DEPTH = 2

N_A = DEPTH // 2
N_B = DEPTH - N_A

A_HEADS = 8
A_QK_DIM = D_MODEL // 2 // A_HEADS
A_V_DIM = D_MODEL // A_HEADS
A_QK_W = A_HEADS * A_QK_DIM
A_V_W = A_HEADS * A_V_DIM
A_IN_WIDTH = 2 * A_QK_W + A_V_W + 2 * A_HEADS + A_V_W
A_CHUNK = 128

B_HEADS = 8
B_Q_LORA = 384
B_KV_LORA = 256
B_NOPE = 128
B_ROPE = 64
B_V = 128
B_QBLOCK = 128
ROPE_THETA = 10000.0

D_FF = 4 * D_MODEL
EPS = 1e-6

kernel_name = "yoco_mlstm_mla_sandwich_adaln"


def rmsnorm(x, g):
    xf = x.astype(jnp.float32)
    y = xf * lax.rsqrt(jnp.mean(xf * xf, axis=-1, keepdims=True) + EPS)
    return (y * g.astype(jnp.float32)).astype(x.dtype)


def modulate(h, shift, scale):
    return h * (1 + scale[:, None, :]) + shift[:, None, :]


def rope_tables(positions):
    half = B_ROPE // 2
    inv = ROPE_THETA ** (-jnp.arange(half, dtype=jnp.float32) / half)
    ang = positions.astype(jnp.float32)[..., None] * inv
    return jnp.cos(ang), jnp.sin(ang)


def apply_rope(x, cos, sin):
    xf = x.astype(jnp.float32)
    x1, x2 = jnp.split(xf, 2, axis=-1)
    out = jnp.concatenate([x1 * cos - x2 * sin, x2 * cos + x1 * sin], axis=-1)
    return out.astype(x.dtype)


def mlstm_chunkwise(q, k, v, i_pre, f_pre):
    B_, H, S, dk = q.shape
    dv = v.shape[-1]
    L = A_CHUNK
    nc = S // L
    f32 = jnp.float32
    qf = q.astype(f32)
    kf = k.astype(f32) * (dk ** -0.5)
    vf = v.astype(f32)
    lf = jax.nn.log_sigmoid(f_pre.astype(f32))
    ig = i_pre.astype(f32)

    def chunks(a):
        return jnp.moveaxis(a.reshape(B_, H, nc, L, *a.shape[3:]), 2, 0)

    qc, kc, vc, ic = chunks(qf), chunks(kf), chunks(vf), chunks(ig)
    bc = jnp.cumsum(chunks(lf), axis=-1)
    tri = jnp.tril(jnp.ones((L, L), dtype=bool))

    def step(carry, xs):
        C, n, m = carry
        qb, kb, vb, ib, bb = xs
        log_d = bb[..., :, None] - bb[..., None, :] + ib[..., None, :]
        log_d = jnp.where(tri, log_d, -jnp.inf)
        log_inter = bb + m[..., None]
        m_t = jnp.maximum(log_inter, jnp.max(log_d, axis=-1))
        w_intra = jnp.exp(log_d - m_t[..., None])
        w_inter = jnp.exp(log_inter - m_t)
        s = jnp.einsum('bhtd,bhsd->bhts', qb, kb) * w_intra
        num = (w_inter[..., None] * jnp.einsum('bhtd,bhde->bhte', qb, C)
               + jnp.einsum('bhts,bhse->bhte', s, vb))
        den = w_inter * jnp.einsum('bhtd,bhd->bht', qb, n) + jnp.sum(s, axis=-1)
        h = num / jnp.maximum(jnp.abs(den), jnp.exp(-m_t))[..., None]
        b_last = bb[..., -1]
        log_w = b_last[..., None] - bb + ib
        m_new = jnp.maximum(b_last + m, jnp.max(log_w, axis=-1))
        w = jnp.exp(log_w - m_new[..., None])
        decay = jnp.exp(b_last + m - m_new)
        C_new = decay[..., None, None] * C + jnp.einsum('bhs,bhsd,bhse->bhde', w, kb, vb)
        n_new = decay[..., None] * n + jnp.einsum('bhs,bhsd->bhd', w, kb)
        return (C_new, n_new, m_new), h

    init = (jnp.zeros((B_, H, dk, dv), f32), jnp.zeros((B_, H, dk), f32), jnp.zeros((B_, H), f32))
    _, hc = lax.scan(step, init, (qc, kc, vc, ic, bc))
    return jnp.moveaxis(hc, 0, 2).reshape(B_, H, S, dv).astype(q.dtype)


def mlstm_mixer(h, w_in, gate_b, head_g, w_out):
    B_, S, _ = h.shape
    proj = h @ w_in
    splits = [A_QK_W, 2 * A_QK_W, 2 * A_QK_W + A_V_W, 2 * A_QK_W + A_V_W + A_HEADS,
              2 * A_QK_W + A_V_W + 2 * A_HEADS]
    q, k, v, ig, fg, og = jnp.split(proj, splits, axis=-1)
    heads = lambda a, d: a.reshape(B_, S, A_HEADS, d).transpose(0, 2, 1, 3)
    i_pre = (ig + gate_b[0]).transpose(0, 2, 1)
    f_pre = (fg + gate_b[1]).transpose(0, 2, 1)
    hh = mlstm_chunkwise(heads(q, A_QK_DIM), heads(k, A_QK_DIM), heads(v, A_V_DIM), i_pre, f_pre)
    hh = rmsnorm(hh.transpose(0, 2, 1, 3), head_g).reshape(B_, S, A_V_W)
    return (hh * jax.nn.sigmoid(og)) @ w_out


def mla_shared_kv(x, shift, scale, g_in, w_a, g_latent, w_b, cos, sin):
    B_, S, _ = x.shape
    h = modulate(rmsnorm(x, g_in), shift, scale)
    kv = h @ w_a
    c_kv, k_rope = jnp.split(kv, [B_KV_LORA], axis=-1)
    c_kv = rmsnorm(c_kv, g_latent)
    kvb = (c_kv @ w_b).reshape(B_, S, B_HEADS, B_NOPE + B_V)
    k_nope, v = jnp.split(kvb, [B_NOPE], axis=-1)
    k_rope = apply_rope(k_rope, cos, sin)
    return k_nope, k_rope, v


def causal_mla_attention(q_nope, q_rope, k_nope, k_rope, v):
    B_, S, H, _ = q_nope.shape
    nb = S // B_QBLOCK
    scale = (B_NOPE + B_ROPE) ** -0.5
    qn = jnp.moveaxis(q_nope.reshape(B_, nb, B_QBLOCK, H, B_NOPE), 1, 0)
    qr = jnp.moveaxis(q_rope.reshape(B_, nb, B_QBLOCK, H, B_ROPE), 1, 0)
    kpos = jnp.arange(S, dtype=jnp.int32)
    starts = jnp.arange(nb, dtype=jnp.int32) * B_QBLOCK

    def block(args):
        qn_b, qr_b, start = args
        s = (jnp.einsum('bqhd,bkhd->bhqk', qn_b, k_nope)
             + jnp.einsum('bqhd,bkd->bhqk', qr_b, k_rope)).astype(jnp.float32) * scale
        qpos = start + jnp.arange(B_QBLOCK, dtype=jnp.int32)
        s = jnp.where(kpos[None, :] <= qpos[:, None], s, -jnp.inf)
        p = jax.nn.softmax(s, axis=-1)
        return jnp.einsum('bhqk,bkhd->bqhd', p.astype(v.dtype), v)

    o = lax.map(block, (qn, qr, starts))
    return jnp.moveaxis(o, 0, 1).reshape(B_, S, H, B_V)


def mla_mixer(h, w_q_a, g_q_latent, w_q_b, w_out, k_nope, k_rope, v, cos, sin):
    B_, S, _ = h.shape
    cq = rmsnorm(h @ w_q_a, g_q_latent)
    q = (cq @ w_q_b).reshape(B_, S, B_HEADS, B_NOPE + B_ROPE)
    q_nope, q_rope = jnp.split(q, [B_NOPE], axis=-1)
    q_rope = apply_rope(q_rope, cos[:, :, None, :], sin[:, :, None, :])
    o = causal_mla_attention(q_nope, q_rope, k_nope, k_rope, v)
    return o.reshape(B_, S, B_HEADS * B_V) @ w_out


def sqrelu_mlp(h, w1, w2):
    return jnp.square(jax.nn.relu(h @ w1)) @ w2


def setup_inputs(seed: int = 0) -> dict:
    key = jax.random.key(seed)
    ks = jax.random.split(key, 24)
    f32 = jnp.float32

    def nrm(k, shape, fan_in, s=1.0):
        return s * (fan_in ** -0.5) * jax.random.normal(k, shape, f32)

    def gain(k, shape):
        return 1.0 + 0.02 * jax.random.normal(k, shape, f32)

    x = jax.random.normal(ks[0], (BATCH, SEQ, D_MODEL), f32)
    c = jax.random.normal(ks[1], (BATCH, D_MODEL), f32)
    positions = (jax.random.randint(ks[2], (BATCH, 1), 0, 4096, dtype=jnp.int32)
                 + jnp.arange(SEQ, dtype=jnp.int32)[None, :])
    ada_w = nrm(ks[3], (DEPTH, D_MODEL, 6 * D_MODEL), D_MODEL, 0.5)
    ada_b = 0.02 * jax.random.normal(ks[4], (DEPTH, 6 * D_MODEL), f32)
    norm_g = gain(ks[5], (DEPTH, 4, D_MODEL))
    a_w_in = nrm(ks[6], (N_A, D_MODEL, A_IN_WIDTH), D_MODEL)
    kg1, kg2 = jax.random.split(ks[7])
    i_bias = 0.1 * jax.random.normal(kg1, (N_A, A_HEADS), f32)
    f_bias = jnp.linspace(3.0, 6.0, A_HEADS, dtype=f32)[None, :] + 0.1 * jax.random.normal(kg2, (N_A, A_HEADS), f32)
    a_gate_b = jnp.stack([i_bias, f_bias], axis=1)
    a_head_g = gain(ks[8], (N_A, A_HEADS, A_V_DIM))
    a_w_out = nrm(ks[9], (N_A, A_V_W, D_MODEL), A_V_W)
    kv_ada_w = nrm(ks[10], (D_MODEL, 2 * D_MODEL), D_MODEL, 0.5)
    kv_ada_b = 0.02 * jax.random.normal(ks[11], (2 * D_MODEL,), f32)
    kv_norm_g = gain(ks[12], (D_MODEL,))
    kv_w_a = nrm(ks[13], (D_MODEL, B_KV_LORA + B_ROPE), D_MODEL)
    kv_latent_g = gain(ks[14], (B_KV_LORA,))
    kv_w_b = nrm(ks[15], (B_KV_LORA, B_HEADS * (B_NOPE + B_V)), B_KV_LORA)
    b_w_q_a = nrm(ks[16], (N_B, D_MODEL, B_Q_LORA), D_MODEL)
    b_q_latent_g = gain(ks[17], (N_B, B_Q_LORA))
    b_w_q_b = nrm(ks[18], (N_B, B_Q_LORA, B_HEADS * (B_NOPE + B_ROPE)), B_Q_LORA)
    b_w_out = nrm(ks[19], (N_B, B_HEADS * B_V, D_MODEL), B_HEADS * B_V)
    mlp_w1 = nrm(ks[20], (DEPTH, D_MODEL, D_FF), D_MODEL)
    mlp_w2 = nrm(ks[21], (DEPTH, D_FF, D_MODEL), D_FF)
    return {"x": x, "c": c, "positions": positions, "ada_w": ada_w, "ada_b": ada_b,
            "norm_g": norm_g, "a_w_in": a_w_in, "a_gate_b": a_gate_b, "a_head_g": a_head_g,
            "a_w_out": a_w_out, "kv_ada_w": kv_ada_w, "kv_ada_b": kv_ada_b, "kv_norm_g": kv_norm_g,
            "kv_w_a": kv_w_a, "kv_latent_g": kv_latent_g, "kv_w_b": kv_w_b, "b_w_q_a": b_w_q_a,
            "b_q_latent_g": b_q_latent_g, "b_w_q_b": b_w_q_b, "b_w_out": b_w_out,
            "mlp_w1": mlp_w1, "mlp_w2": mlp_w2}


def reference(x, c, positions, ada_w, ada_b, norm_g, a_w_in, a_gate_b, a_head_g, a_w_out,
              kv_ada_w, kv_ada_b, kv_norm_g, kv_w_a, kv_latent_g, kv_w_b, b_w_q_a, b_q_latent_g,
              b_w_q_b, b_w_out, mlp_w1, mlp_w2):
    cond = jax.nn.silu(c)
    cos, sin = rope_tables(positions)
    shared_kv = None
    for l in range(DEPTH):
        ada = cond @ ada_w[l] + ada_b[l]
        sh1, sc1, g1, sh2, sc2, g2 = jnp.split(ada, 6, axis=-1)
        h = modulate(rmsnorm(x, norm_g[l, 0]), sh1, sc1)
        if l < N_A:
            y = mlstm_mixer(h, a_w_in[l], a_gate_b[l], a_head_g[l], a_w_out[l])
        else:
            if shared_kv is None:
                kv_shift, kv_scale = jnp.split(cond @ kv_ada_w + kv_ada_b, 2, axis=-1)
                shared_kv = mla_shared_kv(x, kv_shift, kv_scale, kv_norm_g, kv_w_a, kv_latent_g,
                                          kv_w_b, cos, sin)
            k_nope, k_rope, v = shared_kv
            j = l - N_A
            y = mla_mixer(h, b_w_q_a[j], b_q_latent_g[j], b_w_q_b[j], b_w_out[j],
                          k_nope, k_rope, v, cos, sin)
        x = x + g1[:, None, :] * rmsnorm(y, norm_g[l, 1])
        h = modulate(rmsnorm(x, norm_g[l, 2]), sh2, sc2)
        y = sqrelu_mlp(h, mlp_w1[l], mlp_w2[l])
        x = x + g2[:, None, :] * rmsnorm(y, norm_g[l, 3])
    return x
```

```cpp
#include <hip/hip_runtime.h>
#include <hip/hip_cooperative_groups.h>
#include <cstdio>
#include <cstdint>
#include <cmath>
#include <cstring>
namespace cg = cooperative_groups;
namespace pg8 {
#define PG8_LAS __attribute__((address_space(3)))
typedef unsigned short bf16_t;
typedef short bf16x8 __attribute__((ext_vector_type(8)));
typedef float f32x4 __attribute__((ext_vector_type(4)));
typedef unsigned u32x4 __attribute__((ext_vector_type(4)));
constexpr int BM = 256, BK = 64, HALF = 128, HTB = HALF * BK * 2  , STAGE_BYTES = 8 * HTB, NXCD = 8, WGM = 8;

__host__ __device__ __forceinline__ int lds_byte(int r, int c) { const int st = (r >> 4) * 2 + (c >> 5), rr = r & 15, cc = c & 31, ob = rr * 64 + cc * 2; return st * 1024 + (ob ^ (((ob >> 9) & 1) << 5)); }
__host__ __device__ __forceinline__ void stage_rc(int b, int& R, int& C) { const int st = b / 1024, sb = b % 1024, swz = sb ^ (((sb >> 9) & 1) << 5); R = (st >> 1) * 16 + swz / 64; C = (st & 1) * 32 + (swz % 64) / 2; }
__host__ __device__ __forceinline__ int perm32(int rho) { const int n = rho >> 4, i = rho & 15; return 8 * (i >> 2) + 4 * n + (i & 3); }

struct Unit { int pm, pn; };
struct Gemm { const bf16_t* A; const bf16_t* Bt; int M, N, K; };

struct StaticOrder {
    int nM, nN, nwg, G, c;
    __host__ __device__ void init(int M, int N, int G_, int c_) { nM = M / BM; nN = N / BM; nwg = nM * nN; G = G_; c = c_; }
    __host__ __device__ bool next(int i, Unit& u) const {
        const long L = (long)i * G + c; if (L >= nwg) return false;
        int wgid = (int)L; { const int q = nwg / NXCD, r = nwg % NXCD, xcd = wgid % NXCD, off = wgid / NXCD; wgid = (xcd < r ? xcd * (q + 1) : r * (q + 1) + (xcd - r) * q) + off; }
        const int nig = WGM * nN, gid = wgid / nig, fm = gid * WGM, gsz = (nM - fm) < WGM ? (nM - fm) : WGM;
        u.pm = fm + ((wgid % nig) % gsz); u.pn = (wgid % nig) / gsz; return true;
    }
    __device__ __forceinline__ void a_ready(const Unit&) const {}
    __device__ __forceinline__ void done(const Unit&) const {}
};

__device__ __forceinline__ unsigned cvt_pk_bf16(float lo, float hi) { unsigned r; asm volatile("v_cvt_pk_bf16_f32 %0, %1, %2" : "=v"(r) : "v"(lo), "v"(hi)); return r; }
typedef float f32x2 __attribute__((ext_vector_type(2)));
__device__ __forceinline__ f32x2 gelu_pk(f32x2 v) {
    const f32x2 av = __builtin_elementwise_abs(v), d = av * 0.2316418882f + 1.0f;
    f32x2 t; t.x = __builtin_amdgcn_rcpf(d.x); t.y = __builtin_amdgcn_rcpf(d.y);
    f32x2 q = t * 0.5307027145f + (-0.7265760135f); q = q * t + 0.7107068705f; q = q * t + (-0.142248368f); q = q * t + 0.127414796f; q = q * t;
    const f32x2 s = (v * v) * (-0.72134752044f);
    f32x2 e; e.x = __builtin_amdgcn_exp2f(s.x); e.y = __builtin_amdgcn_exp2f(s.y);
    const f32x2 m = v * (q * e), r = v - m;
    f32x2 o; o.x = v.x < 0.f ? m.x : r.x; o.y = v.y < 0.f ? m.y : r.y; return o;
}

template <int ACT  > struct EpiBf16 {
    static constexpr bool PERM = true, AFTER_DRAIN = false; static_assert(ACT == 0 || ACT == 1, "EpiBf16: ACT is 0 (none) or 1 (gelu_pk)");
    bf16_t* O; int ldc; const float* bias; int split_cols; size_t split_stride; float scale0;
    __device__ __forceinline__ void operator()(const f32x4 (&acc)[2][2][4][2], const Unit& u, int wr, int wc, int fr, int fq) const {
        const int row0 = u.pm * BM + wr * 64 + fr; int colt = u.pn * BM; bf16_t* base = O;
        float sc = 1.f; if (split_cols) { const int t = colt / split_cols; base += (size_t)t * split_stride; colt -= t * split_cols; if (t == 0) sc = scale0; }
        const int col0 = colt + wc * 32 + 8 * fq, bcol0 = u.pn * BM + wc * 32 + 8 * fq;
        f32x4 bv[2][2];
#pragma unroll
        for (int bj = 0; bj < 2; ++bj)
#pragma unroll
            for (int n = 0; n < 2; ++n) bv[bj][n] = bias ? *(const f32x4*)(bias + bcol0 + bj * HALF + 4 * n) : (f32x4){0.f, 0.f, 0.f, 0.f};
#pragma unroll
        for (int ai = 0; ai < 2; ++ai)
#pragma unroll
            for (int m = 0; m < 4; ++m) { bf16_t* rowp = base + (size_t)(row0 + ai * HALF + m * 16) * ldc + col0;
#pragma unroll
                for (int bj = 0; bj < 2; ++bj) { f32x4 v0 = acc[ai][bj][m][0] + bv[bj][0], v1 = acc[ai][bj][m][1] + bv[bj][1];
                    if (ACT == 1) { f32x2 a = gelu_pk((f32x2){v0[0], v0[1]}), b = gelu_pk((f32x2){v0[2], v0[3]}), c = gelu_pk((f32x2){v1[0], v1[1]}), d = gelu_pk((f32x2){v1[2], v1[3]});
                        v0 = (f32x4){a.x, a.y, b.x, b.y}; v1 = (f32x4){c.x, c.y, d.x, d.y}; }
                    v0 = v0 * sc; v1 = v1 * sc; u32x4 w; w.x = cvt_pk_bf16(v0[0], v0[1]); w.y = cvt_pk_bf16(v0[2], v0[3]); w.z = cvt_pk_bf16(v1[0], v1[1]); w.w = cvt_pk_bf16(v1[2], v1[3]);
                    *(u32x4*)(rowp + bj * HALF) = w; } }
    }
};

template <int ACT  > struct EpiOut {
    static constexpr bool PERM = true, AFTER_DRAIN = false;
    bf16_t* O; int ldc;
    __device__ __forceinline__ void operator()(const f32x4 (&acc)[2][2][4][2], const Unit& u, int wr, int wc, int fr, int fq) const {
        const int row0 = u.pm * BM + wr * 64 + fr; const int col0 = u.pn * BM + wc * 32 + 8 * fq;
#pragma unroll
        for (int ai = 0; ai < 2; ++ai)
#pragma unroll
            for (int m = 0; m < 4; ++m) { bf16_t* rowp = O + (size_t)(row0 + ai * HALF + m * 16) * ldc + col0;
#pragma unroll
                for (int bj = 0; bj < 2; ++bj) { f32x4 v0 = acc[ai][bj][m][0], v1 = acc[ai][bj][m][1];
                    if (ACT == 2) {
#pragma unroll
                        for (int e = 0; e < 4; ++e) { float a = fmaxf(v0[e], 0.f), b = fmaxf(v1[e], 0.f); v0[e] = a * a; v1[e] = b * b; } }
                    u32x4 w; w.x = cvt_pk_bf16(v0[0], v0[1]); w.y = cvt_pk_bf16(v0[2], v0[3]); w.z = cvt_pk_bf16(v1[0], v1[1]); w.w = cvt_pk_bf16(v1[2], v1[3]);
                    *(u32x4*)(rowp + bj * HALF) = w; } }
    }
};
struct EpiProj {
    static constexpr bool PERM = true, AFTER_DRAIN = false;
    bf16_t* O; int ldc; float* G; int npn;
    __device__ __forceinline__ void operator()(const f32x4 (&acc)[2][2][4][2], const Unit& u, int wr, int wc, int fr, int fq) const {
        const int row0 = u.pm * BM + wr * 64 + fr;
        if (u.pn < npn) {
            const int col0 = u.pn * BM + wc * 32 + 8 * fq;
#pragma unroll
            for (int ai = 0; ai < 2; ++ai)
#pragma unroll
                for (int m = 0; m < 4; ++m) { bf16_t* rowp = O + (size_t)(row0 + ai * HALF + m * 16) * ldc + col0;
#pragma unroll
                    for (int bj = 0; bj < 2; ++bj) { const f32x4 v0 = acc[ai][bj][m][0], v1 = acc[ai][bj][m][1];
                        u32x4 w; w.x = cvt_pk_bf16(v0[0], v0[1]); w.y = cvt_pk_bf16(v0[2], v0[3]); w.z = cvt_pk_bf16(v1[0], v1[1]); w.w = cvt_pk_bf16(v1[2], v1[3]);
                        *(u32x4*)(rowp + bj * HALF) = w; } }
        } else if (wc == 0 && fq < 2) {
#pragma unroll
            for (int ai = 0; ai < 2; ++ai)
#pragma unroll
                for (int m = 0; m < 4; ++m) { float* gp = G + (size_t)(row0 + ai * HALF + m * 16) * 16 + 8 * fq;
                    *(f32x4*)gp = acc[ai][0][m][0]; *(f32x4*)(gp + 4) = acc[ai][0][m][1]; }
        }
    }
};
template <class Epi, class Sched, bool ALIGN_EPI = false, bool SP2 = false>
__device__ __forceinline__ void gemm_phase(PG8_LAS unsigned char* lds, const Gemm g, const Sched& S, const Epi& E) {
    int tid_o = threadIdx.x; asm volatile("" : "+v"(tid_o));
    const int tid = tid_o, wid = __builtin_amdgcn_readfirstlane(tid >> 6), lane = tid & 63, wr = wid >> 2, wc = wid & 3, fr = lane & 15, fq = lane >> 4;
    const int K = g.K, nt = K / BK;
    unsigned voffA[2], voffB[2];
#pragma unroll
    for (int i = 0; i < 2; ++i) { int R, C; stage_rc(tid * 16 + i * 8192, R, C); const int Rb = Epi::PERM ? ((R & ~31) + perm32(R & 31)) : R;
        voffA[i] = (unsigned)(R * K + C) * 2u; voffB[i] = (unsigned)(Rb * K + C) * 2u; }
    const size_t kstep = (size_t)(BK * 2);
    const size_t hstep = (size_t)HALF * K * 2;
    const size_t tstep = 2 * hstep;
    const unsigned ldsw = (unsigned)wid * 1024u;
    const int aoff = lds_byte(wr * 64 + fr, fq * 8), boff = lds_byte(wc * 32 + fr, fq * 8);
#define PG8_SA(b, h) (((b) * 2 + (h)) * HTB)
#define PG8_SB(b, h) ((4 + (b) * 2 + (h)) * HTB)
#define PG8_STAGE(bufoff, gbase, voff) do { _Pragma("unroll") for (int _i = 0; _i < 2; ++_i) \
        __builtin_amdgcn_global_load_lds((const unsigned*)((const char*)(gbase) + (voff)[_i]), (PG8_LAS unsigned*)(lds + (bufoff) + ldsw + _i * 8192), 16, 0, 0); } while (0)
#define PG8_LDA(dst, b, h) do { _Pragma("unroll") for (int m = 0; m < 4; ++m) _Pragma("unroll") for (int k = 0; k < 2; ++k) dst[m][k] = *(const PG8_LAS bf16x8*)(lds + PG8_SA(b, h) + aoff + m * 2048 + k * 1024); } while (0)
#define PG8_LDB(dst, b, h) do { _Pragma("unroll") for (int n = 0; n < 2; ++n) _Pragma("unroll") for (int k = 0; k < 2; ++k) dst[n][k] = *(const PG8_LAS bf16x8*)(lds + PG8_SB(b, h) + boff + n * 2048 + k * 1024); } while (0)
#define PG8_MMA(ai, bj, At, Bt) do { __builtin_amdgcn_s_setprio(1); _Pragma("unroll") for (int m = 0; m < 4; ++m) _Pragma("unroll") for (int n = 0; n < 2; ++n) _Pragma("unroll") for (int k = 0; k < 2; ++k) \
        acc[ai][bj][m][n] = __builtin_amdgcn_mfma_f32_16x16x32_bf16(Bt[n][k], At[m][k], acc[ai][bj][m][n], 0, 0, 0); __builtin_amdgcn_s_setprio(0); } while (0)
#define PG8_WAIT_V(n) asm volatile("s_waitcnt vmcnt(" #n ")" ::: "memory")
#define PG8_WAIT_L(n) asm volatile("s_waitcnt lgkmcnt(" #n ")" ::: "memory")
#define PG8_BAR __builtin_amdgcn_s_barrier()
#define PG8_SCHED __builtin_amdgcn_sched_barrier(0)
    Unit cur, nxt; int ui = 0;
    if (!S.next(0, cur)) return;
    f32x4 acc[2][2][4][2];
#pragma unroll
    for (int a = 0; a < 2; ++a)
#pragma unroll
        for (int b = 0; b < 2; ++b)
#pragma unroll
            for (int m = 0; m < 4; ++m)
#pragma unroll
                for (int n = 0; n < 2; ++n) acc[a][b][m][n] = (f32x4){0.f, 0.f, 0.f, 0.f};
    bf16x8 At[4][2], B0[2][2], B1[2][2];
    const char* cA = (const char*)g.A + (size_t)cur.pm * tstep; const char* cB = (const char*)g.Bt + (size_t)cur.pn * tstep;
    S.a_ready(cur);
    if constexpr (SP2) {
        PG8_STAGE(PG8_SB(0, 0), cB, voffB); PG8_STAGE(PG8_SB(0, 1), cB + hstep, voffB); PG8_STAGE(PG8_SA(0, 0), cA, voffA); PG8_STAGE(PG8_SA(0, 1), cA + hstep, voffA);
        if (wr == 1) PG8_BAR;
        PG8_WAIT_V(2); PG8_BAR;
        PG8_STAGE(PG8_SB(1, 0), cB + kstep, voffB); PG8_STAGE(PG8_SA(1, 0), cA + kstep, voffA); PG8_STAGE(PG8_SB(1, 1), cB + hstep + kstep, voffB);
        PG8_WAIT_V(6); PG8_BAR;
    } else {
        PG8_STAGE(PG8_SB(0, 0), cB, voffB); PG8_STAGE(PG8_SA(0, 0), cA, voffA); PG8_STAGE(PG8_SB(0, 1), cB + hstep, voffB); PG8_STAGE(PG8_SA(0, 1), cA + hstep, voffA);
        if (wr == 1) PG8_BAR;
        PG8_WAIT_V(4); PG8_BAR;
        PG8_STAGE(PG8_SB(1, 0), cB + kstep, voffB); PG8_STAGE(PG8_SA(1, 0), cA + kstep, voffA); PG8_STAGE(PG8_SB(1, 1), cB + hstep + kstep, voffB);
        PG8_WAIT_V(6); PG8_BAR;
    }
    for (;;) {
        const bool has_next = S.next(ui + 1, nxt);
        const char* nA = has_next ? (const char*)g.A + (size_t)nxt.pm * tstep : cA; const char* nB = has_next ? (const char*)g.Bt + (size_t)nxt.pn * tstep : cB;
        for (int t = 0; t < nt; t += 2) {
            const bool last = (t == nt - 2);
            const char* a1 = cA + (size_t)(t + 1) * kstep;
            const char* a2 = last ? nA : cA + (size_t)(t + 2) * kstep; const char* b2 = last ? nB : cB + (size_t)(t + 2) * kstep;
            const char* a3 = a2 + kstep; const char* b3 = b2 + kstep;
            if (last && has_next) S.a_ready(nxt);
            if constexpr (SP2) {
            PG8_LDB(B0, 0, 0); PG8_LDB(B1, 0, 1); PG8_SCHED; PG8_LDA(At, 0, 0); PG8_STAGE(PG8_SA(1, 1), a1 + hstep, voffA);
            PG8_WAIT_V(8); PG8_WAIT_L(0); PG8_BAR; PG8_MMA(0, 0, At, B0); PG8_MMA(0, 1, At, B1); PG8_BAR; PG8_SCHED;
            PG8_LDA(At, 0, 1); PG8_STAGE(PG8_SB(0, 0), b2, voffB); PG8_STAGE(PG8_SB(0, 1), b2 + hstep, voffB); PG8_STAGE(PG8_SA(0, 0), a2, voffA);
            PG8_WAIT_V(8); PG8_WAIT_L(0); PG8_BAR; PG8_MMA(1, 0, At, B0); PG8_MMA(1, 1, At, B1); PG8_BAR; PG8_SCHED;
            PG8_LDB(B0, 1, 0); PG8_LDB(B1, 1, 1); PG8_SCHED; PG8_LDA(At, 1, 0); PG8_STAGE(PG8_SA(0, 1), a2 + hstep, voffA);
            PG8_WAIT_V(8); PG8_WAIT_L(0); PG8_BAR; PG8_MMA(0, 0, At, B0); PG8_MMA(0, 1, At, B1); PG8_BAR; PG8_SCHED;
            PG8_LDA(At, 1, 1); PG8_STAGE(PG8_SB(1, 0), b3, voffB); PG8_STAGE(PG8_SB(1, 1), b3 + hstep, voffB); PG8_STAGE(PG8_SA(1, 0), a3, voffA);
            PG8_WAIT_V(8); PG8_WAIT_L(0); PG8_BAR; PG8_MMA(1, 0, At, B0); PG8_MMA(1, 1, At, B1); PG8_BAR; PG8_SCHED;
            } else {
            PG8_LDB(B0, 0, 0); PG8_SCHED; PG8_LDA(At, 0, 0); PG8_STAGE(PG8_SA(1, 1), a1 + hstep, voffA);
            PG8_WAIT_L(8); PG8_BAR; PG8_WAIT_L(0); PG8_MMA(0, 0, At, B0); PG8_BAR; PG8_SCHED;
            PG8_LDB(B1, 0, 1); PG8_STAGE(PG8_SB(0, 0), b2, voffB);
            PG8_BAR; PG8_WAIT_L(0); PG8_MMA(0, 1, At, B1); PG8_BAR;
            PG8_LDA(At, 0, 1); PG8_STAGE(PG8_SA(0, 0), a2, voffA);
            PG8_BAR; PG8_WAIT_L(0); PG8_MMA(1, 0, At, B0); PG8_BAR; PG8_SCHED;
            PG8_STAGE(PG8_SB(0, 1), b2 + hstep, voffB);
            PG8_WAIT_V(6); PG8_BAR; PG8_MMA(1, 1, At, B1); PG8_BAR;
            PG8_LDB(B0, 1, 0); PG8_SCHED; PG8_LDA(At, 1, 0); PG8_STAGE(PG8_SA(0, 1), a2 + hstep, voffA);
            PG8_WAIT_L(8); PG8_BAR; PG8_WAIT_L(0); PG8_MMA(0, 0, At, B0); PG8_BAR; PG8_SCHED;
            PG8_LDB(B1, 1, 1); PG8_STAGE(PG8_SB(1, 0), b3, voffB);
            PG8_BAR; PG8_WAIT_L(0); PG8_MMA(0, 1, At, B1); PG8_BAR;
            PG8_LDA(At, 1, 1); PG8_STAGE(PG8_SA(1, 0), a3, voffA);
            PG8_BAR; PG8_WAIT_L(0); PG8_MMA(1, 0, At, B0); PG8_BAR; PG8_SCHED;
            PG8_STAGE(PG8_SB(1, 1), b3 + hstep, voffB);
            PG8_WAIT_V(6); PG8_BAR; PG8_MMA(1, 1, At, B1); PG8_BAR;
            }
        }
        if constexpr (ALIGN_EPI) { if (wr == 0) PG8_BAR; }
        if constexpr (!Epi::AFTER_DRAIN) { E(acc, cur, wr, wc, fr, fq); S.done(cur); }
        if (!has_next) break;
#pragma unroll
        for (int a = 0; a < 2; ++a)
#pragma unroll
            for (int b = 0; b < 2; ++b)
#pragma unroll
                for (int m = 0; m < 4; ++m)
#pragma unroll
                    for (int n = 0; n < 2; ++n) acc[a][b][m][n] = (f32x4){0.f, 0.f, 0.f, 0.f};
        cur = nxt; cA = nA; cB = nB; ++ui;
        if constexpr (ALIGN_EPI) { if (wr == 1) PG8_BAR; }
    }
    PG8_WAIT_V(0);
    if constexpr (!ALIGN_EPI) { if (wr == 0) PG8_BAR; }
    PG8_BAR;
    if constexpr (Epi::AFTER_DRAIN) { E.fused(acc, cur, wr, wc, fr, fq, lds, wid, lane); S.done(cur); }
#undef PG8_SA
#undef PG8_SB
#undef PG8_STAGE
#undef PG8_LDA
#undef PG8_LDB
#undef PG8_MMA
#undef PG8_WAIT_V
#undef PG8_WAIT_L
#undef PG8_BAR
#undef PG8_SCHED
}
}
#ifndef PG8_SP2
#define PG8_SP2 true
#endif
#ifndef PG8_ALIGN
#define PG8_ALIGN true
#endif
#ifndef MK_MULTI
#define MK_MULTI 0
#endif

constexpr int NB = 4, S = 8192, D = 1024, T = NB * S, FF = 4096;
constexpr int NWAVES = 8, NTHR = 512;
constexpr float EPS = 1e-6f;
constexpr int NPHASE = 20;

constexpr size_t MiB = 1u << 20;
constexpr size_t WS_ADA = 1 * MiB;
constexpr size_t WS_COS = 2 * MiB, WS_SIN = 6 * MiB;
constexpr size_t WS_G = 10 * MiB;
constexpr size_t WS_AARR = 12 * MiB, WS_BARR = 13 * MiB, WS_CMARR = 14 * MiB;
constexpr size_t WS_AMAX = 15 * MiB, WS_BL = 15 * MiB + 8192, WS_MPREV = 15 * MiB + 16384;
constexpr size_t WS_W = 16 * MiB;
constexpr size_t W_IN = WS_W, W_V = W_IN + (size_t)2304 * 1024 * 2, W_AO = W_V + (size_t)1024 * 1024 * 2;
constexpr size_t W_1A = W_AO + 2 * MiB, W_2A = W_1A + 8 * MiB, W_1B = W_2A + 8 * MiB, W_2B = W_1B + 8 * MiB;
constexpr size_t W_KVA = W_2B + 8 * MiB, W_BK = W_KVA + 1 * MiB, W_BV = W_BK + MiB / 2, W_QA = W_BV + MiB / 2, W_QB = W_QA + 1 * MiB, W_BO = W_QB + (size_t)1536 * 384 * 2, W_END = W_BO + 2 * MiB;
static_assert(W_END <= 64 * MiB, "weights region");
constexpr size_t WS_Y = 64 * MiB;
constexpr size_t WS_CIN = 64 * MiB, WS_DN = 96 * MiB, WS_NIN = 97 * MiB;
constexpr size_t WS_H = 128 * MiB;
constexpr size_t WS_H2 = 192 * MiB;
constexpr size_t WS_CST = 192 * MiB;
constexpr size_t WS_Q = 128 * MiB;
constexpr size_t WS_R = 256 * MiB;
constexpr size_t WS_P = WS_R, WS_VTA = WS_R + 128 * MiB;
constexpr size_t WS_U = WS_R;
constexpr size_t WS_KVA = WS_R, WS_QA = WS_R + 32 * MiB, WS_CKV = WS_R + 64 * MiB, WS_KR = WS_R + 80 * MiB, WS_CQ = WS_R + 84 * MiB, WS_KN = WS_R + 108 * MiB, WS_VTB = WS_R + 172 * MiB;
constexpr size_t WS_O = WS_R;
constexpr size_t WS_END = 512 * MiB;
static_assert(WS_VTB + 64 * MiB <= WS_END, "ws map");

constexpr int LDS_BYTES = 147456;

#define LAS __attribute__((address_space(3)))
typedef unsigned short bf16;
typedef unsigned v4u __attribute__((ext_vector_type(4)));
typedef unsigned v2u __attribute__((ext_vector_type(2)));
typedef float f32x4 __attribute__((ext_vector_type(4)));
typedef float f32x2 __attribute__((ext_vector_type(2)));
typedef float f32x16 __attribute__((ext_vector_type(16)));
typedef short bf16x8 __attribute__((ext_vector_type(8)));
typedef short s16x4 __attribute__((ext_vector_type(4)));
typedef __bf16 bf2_t __attribute__((ext_vector_type(2)));
#define DI __device__ __forceinline__
#define MFMA32(a, b, c) __builtin_amdgcn_mfma_f32_32x32x16_bf16((a), (b), (c), 0, 0, 0)

DI unsigned pk2(float lo, float hi) { f32x2 v = {lo, hi}; bf2_t r = __builtin_convertvector(v, bf2_t); return __builtin_bit_cast(unsigned, r); }
DI float bflo(unsigned u) { return __uint_as_float(u << 16); }
DI float bfhi(unsigned u) { return __uint_as_float(u & 0xffff0000u); }
DI float bf2f(short s) { return __uint_as_float(((unsigned)(unsigned short)s) << 16); }
DI int crow(int i, int h) { return (i & 3) + 8 * (i >> 2) + 4 * h; }
DI float wave_sum(float v) {
#pragma unroll
    for (int o = 1; o < 64; o <<= 1) v += __shfl_xor(v, o);
    return v;
}
DI bf16x8 pack8(float a0, float a1, float a2, float a3, float a4, float a5, float a6, float a7) {
    v4u p; p.x = pk2(a0, a1); p.y = pk2(a2, a3); p.z = pk2(a4, a5); p.w = pk2(a6, a7); return __builtin_bit_cast(bf16x8, p);
}


typedef __attribute__((address_space(1))) unsigned gu32;
#define RLX_AGENT __ATOMIC_RELAXED, __HIP_MEMORY_SCOPE_AGENT
constexpr int CW_BAR = 4096;
constexpr size_t CTL_ZERO_BYTES = 65536;
constexpr int MISC_OFF = 135168;
#define XB_TMO      128
#define XB_XCNT(j)  (256  + 64 * (j))
#define XB_XSUB(j)  (1280 + 64 * (j))
#define XB_XGEN(j)  (2304 + 64 * (j))
#define XB_TOP      3328
#define XB_TOPGEN   3392
#define XCD_BAR_WORDS 3456
#define XB_SPIN_CAP (1u << 18)

__device__ __forceinline__ unsigned xb_ld(unsigned* p)              { return __hip_atomic_load(p, __ATOMIC_RELAXED, __HIP_MEMORY_SCOPE_AGENT); }
__device__ __forceinline__ unsigned xb_add(unsigned* p, unsigned v) { return __hip_atomic_fetch_add(p, v, __ATOMIC_RELAXED, __HIP_MEMORY_SCOPE_AGENT); }
__device__ __forceinline__ unsigned xb_xcc_id() { return (unsigned)__builtin_amdgcn_s_getreg((3 << 11) | 20) & 0xFu; }
#define XB_SPIN(cond, bar) do { unsigned _sp = 0; while (cond) { __builtin_amdgcn_s_sleep(1); \
    if ((++_sp & 255u) == 0u) { if (xb_ld(&(bar)[XB_TMO])) break; if (_sp > XB_SPIN_CAP) { atomicAdd(&(bar)[XB_TMO], 1u); break; } } } } while (0)

struct XcdBarrier {
    unsigned* bar; unsigned x;
    volatile LAS unsigned* st;
};

__device__ __forceinline__ XcdBarrier xcd_barrier_post(unsigned* bar, volatile LAS unsigned* st) {
    XcdBarrier b; b.bar = bar; b.x = xb_xcc_id(); b.st = st;
    if (threadIdx.x == 0) (void)xb_add(&bar[XB_XCNT(b.x)], 1u);
    return b;
}
__device__ __forceinline__ void xcd_barrier_complete(unsigned* bar, unsigned x, unsigned& nloc, unsigned& nx) {
    const unsigned G = gridDim.x * gridDim.y * gridDim.z;
    unsigned sum, cnt, mine, sp = 0u;
    for (;;) {
        sum = 0u; cnt = 0u; mine = 0u;
#pragma unroll
        for (unsigned j = 0; j < 16; ++j) { const unsigned c = xb_ld(&bar[XB_XCNT(j)]); sum += c; cnt += (c > 0u) ? 1u : 0u; mine = (j == x) ? c : mine; }
        if (sum == G) break;
        __builtin_amdgcn_s_sleep(1);
        if ((++sp & 255u) == 0u) { if (xb_ld(&bar[XB_TMO])) break; if (sp > XB_SPIN_CAP) { atomicAdd(&bar[XB_TMO], 1u); break; } }
    }
    nloc = mine > 0u ? mine : 1u; nx = cnt > 0u ? cnt : 1u;
}

__device__ __forceinline__ void xcd_barrier(const XcdBarrier& b) {
    asm volatile("s_waitcnt vmcnt(0)" ::: "memory");
    __syncthreads();
    if (threadIdx.x == 0) {
        unsigned* bar = b.bar;
        __builtin_amdgcn_s_waitcnt(0);
        unsigned nloc = b.st[0], nx = b.st[1];
        if (nloc == 0u) { xcd_barrier_complete(bar, b.x, nloc, nx); b.st[0] = nloc; b.st[1] = nx; }
        const unsigned old = xb_add(&bar[XB_XSUB(b.x)], 1u);
        const unsigned gen = old / nloc;
        if (old + 1u == (gen + 1u) * nloc) {
            __builtin_amdgcn_fence(__ATOMIC_RELEASE, "agent");
            asm volatile("s_waitcnt vmcnt(0)" ::: "memory");
            const unsigned og = xb_add(&bar[XB_TOP], 1u);
            const unsigned tg = og / nx;
            if (og + 1u == (tg + 1u) * nx) xb_add(&bar[XB_TOPGEN], 1u);
            else XB_SPIN(xb_ld(&bar[XB_TOPGEN]) == tg, bar);
            __builtin_amdgcn_fence(__ATOMIC_ACQUIRE, "agent");
            xb_add(&bar[XB_XGEN(b.x)], 1u);
            asm volatile("s_waitcnt vmcnt(0)" ::: "memory");
        } else {
            XB_SPIN(xb_ld(&bar[XB_XGEN(b.x)]) == gen, bar);
            __builtin_amdgcn_fence(__ATOMIC_ACQUIRE, "agent");
            asm volatile("s_waitcnt vmcnt(0)" ::: "memory");
        }
    }
    __syncthreads();
}


struct Args {
    const float* in[22]; float* out; unsigned char* ws; float inv_freq[32]; int ph_lo, ph_hi;
};

struct Frame {
    LAS unsigned char* lds; int tid, lane, wave, G, bid;
};

struct TrItem { const float* W; bf16* WT; int ldw, col0, nvalid, K, row0, kb, nb; };
DI void tr_load(const TrItem& t, int lane, f32x4 (&v)[8]) {
    const int k0 = 64 * t.kb, n0 = 32 * t.nb; const int c4 = lane & 7, kr = lane >> 3; const bool ok = (n0 + 4 * c4) < t.nvalid;
#pragma unroll
    for (int i = 0; i < 8; ++i) v[i] = ok ? *(const f32x4*)(t.W + (size_t)(k0 + 8 * i + kr) * t.ldw + t.col0 + n0 + 4 * c4) : (f32x4){0.f, 0.f, 0.f, 0.f};
}
DI void tr_finish(const TrItem& t, int lane, const f32x4 (&v)[8], LAS float* scr) {
    const int k0 = 64 * t.kb, n0 = 32 * t.nb; const int c4 = lane & 7, kr = lane >> 3;
#pragma unroll
    for (int i = 0; i < 8; ++i) { LAS float* d = scr + (8 * i + kr) * 33 + 4 * c4; d[0] = v[i].x; d[1] = v[i].y; d[2] = v[i].z; d[3] = v[i].w; }
    asm volatile("s_waitcnt lgkmcnt(0)" ::: "memory");
    const int ch = lane & 7;
#pragma unroll
    for (int j = 0; j < 4; ++j) { const int n = (lane >> 3) + 8 * j; const LAS float* s = scr + (8 * ch) * 33 + n;
        v4u o; o.x = pk2(s[0 * 33], s[1 * 33]); o.y = pk2(s[2 * 33], s[3 * 33]); o.z = pk2(s[4 * 33], s[5 * 33]); o.w = pk2(s[6 * 33], s[7 * 33]);
        *(v4u*)(t.WT + (size_t)(t.row0 + n0 + n) * t.K + k0 + 8 * ch) = o; }
    asm volatile("s_waitcnt lgkmcnt(0)" ::: "memory");
}
constexpr int TR_TOTAL = 512 * 4 + 128 + 2048 * 4 + 256 + 16 * 16 + 256 + 288 + 512;
DI void tr_decode(const Args& a, int g, TrItem& t) {
    unsigned char* ws = a.ws; const float* w_in = a.in[6];
#define TR_JOB(n_, W_, ldw_, col0_, nvalid_, K_, WT_, row0_, nrows_) if (g < (n_)) { t.W = (W_); t.ldw = (ldw_); t.col0 = (col0_); t.nvalid = (nvalid_); t.K = (K_); t.WT = (bf16*)(WT_); t.row0 = (row0_); \
        const int nblk_ = (nrows_) / 32; t.kb = g / nblk_; t.nb = g % nblk_; return; } g -= (n_);
    TR_JOB(512, w_in, 3088, 0, 1024, 1024, ws + W_IN, 0, 1024)
    TR_JOB(512, w_in, 3088, 2064, 1024, 1024, ws + W_IN, 1024, 1024)
    TR_JOB(128, w_in, 3088, 2048, 16, 1024, ws + W_IN, 2048, 256)
    TR_JOB(512, w_in, 3088, 1024, 1024, 1024, ws + W_V, 0, 1024)
    TR_JOB(512, a.in[9], 1024, 0, 1024, 1024, ws + W_AO, 0, 1024)
    TR_JOB(2048, a.in[20], 4096, 0, 4096, 1024, ws + W_1A, 0, 4096)
    TR_JOB(2048, a.in[21], 1024, 0, 1024, 4096, ws + W_2A, 0, 1024)
    TR_JOB(2048, a.in[20] + (size_t)1024 * 4096, 4096, 0, 4096, 1024, ws + W_1B, 0, 4096)
    TR_JOB(2048, a.in[21] + (size_t)4096 * 1024, 1024, 0, 1024, 4096, ws + W_2B, 0, 1024)
    TR_JOB(256, a.in[13], 320, 0, 320, 1024, ws + W_KVA, 0, 512)
    { const int j = g >> 4;
      if (j < 16) { const int h = j >> 1, isv = j & 1; g &= 15; t.W = a.in[15]; t.ldw = 2048; t.col0 = h * 256 + 128 * isv; t.nvalid = 128; t.K = 256; t.WT = (bf16*)(ws + (isv ? W_BV : W_BK)); t.row0 = h * 128;
                    t.kb = g / 4; t.nb = g % 4; return; }
      g -= 256; }
    TR_JOB(256, a.in[16], 384, 0, 384, 1024, ws + W_QA, 0, 512)
    TR_JOB(288, a.in[18], 1536, 0, 1536, 384, ws + W_QB, 0, 1536)
    TR_JOB(512, a.in[19], 1024, 0, 1024, 1024, ws + W_BO, 0, 1024)
#undef TR_JOB
}
DI void p0_weights(Frame& F, const Args& a) {
    LAS float* scr = (LAS float*)(F.lds + F.wave * 16384);
    const int gw = F.bid * NWAVES + F.wave, NGW = F.G * NWAVES;
    int g = gw; if (g >= TR_TOTAL) return;
    TrItem cur; f32x4 v[8];
    tr_decode(a, g, cur); tr_load(cur, F.lane, v);
    for (;;) {
        const int gn = g + NGW; const bool hn = gn < TR_TOTAL;
        TrItem nx; f32x4 vn[8];
        if (hn) { tr_decode(a, gn, nx); tr_load(nx, F.lane, vn); }
        tr_finish(cur, F.lane, v, scr);
        if (!hn) break;
        cur = nx; g = gn;
#pragma unroll
        for (int i = 0; i < 8; ++i) v[i] = vn[i];
    }
}

DI void p0_ada(Frame& F, const Args& a) {
    LAS float* cond = (LAS float*)F.lds;
    LAS float* part = (LAS float*)(F.lds + 16384);
    const float* c = a.in[1];
    __syncthreads();
    for (int i = F.tid; i < 4096; i += NTHR) { const float v = c[i]; cond[i] = v / (1.f + __expf(-v)); }
    __syncthreads();
    float* ADA = (float*)(a.ws + WS_ADA);
    constexpr int NI = 96 + 96 + 32;
    for (int it = F.bid; it < NI; it += F.G) {
        const float* W; const float* bias; int N, n0; float* out;
        if (it < 96) { W = a.in[3]; bias = a.in[4]; N = 6144; n0 = it * 64; out = ADA; }
        else if (it < 192) { W = a.in[3] + (size_t)1024 * 6144; bias = a.in[4] + 6144; N = 6144; n0 = (it - 96) * 64; out = ADA + 4 * 6144; }
        else { W = a.in[10]; bias = a.in[11]; N = 2048; n0 = (it - 192) * 64; out = ADA + 8 * 6144; }
        float s0 = 0.f, s1 = 0.f, s2 = 0.f, s3 = 0.f;
        const float* wp = W + (size_t)(F.wave * 128) * N + n0 + F.lane;
#pragma unroll 32
        for (int k = 0; k < 128; ++k) { const float w = wp[(size_t)k * N]; const int kk = F.wave * 128 + k;
            s0 += cond[kk] * w; s1 += cond[1024 + kk] * w; s2 += cond[2048 + kk] * w; s3 += cond[3072 + kk] * w; }
        part[(F.wave * 4 + 0) * 64 + F.lane] = s0; part[(F.wave * 4 + 1) * 64 + F.lane] = s1; part[(F.wave * 4 + 2) * 64 + F.lane] = s2; part[(F.wave * 4 + 3) * 64 + F.lane] = s3;
        __syncthreads();
        if (F.tid < 256) { const int b = F.tid >> 6, l = F.tid & 63; float s = 0.f;
#pragma unroll
            for (int w = 0; w < 8; ++w) s += part[(w * 4 + b) * 64 + l];
            out[(size_t)b * N + n0 + l] = s + bias[n0 + l]; }
        __syncthreads();
    }
}
DI void p0_rope(Frame& F, const Args& a) {
    const int* pos = (const int*)a.in[2];
    float* COS = (float*)(a.ws + WS_COS); float* SIN = (float*)(a.ws + WS_SIN);
    const int i = F.tid & 31; const float inv = a.inv_freq[i];
    const int tpw = T / (F.G * 16), t0 = (F.bid * 16 + (F.tid >> 5)) * tpw;
    for (int tb = 0; tb < tpw; tb += 8) {
        int p[8];
#pragma unroll
        for (int j = 0; j < 8; ++j) p[j] = pos[t0 + tb + j];
#pragma unroll
        for (int j = 0; j < 8; ++j) { const int t = t0 + tb + j;
            const float ang = (float)p[j] * inv;
            const double rev = (double)ang * 0.15915494309189533577;
            const float fr = (float)__builtin_amdgcn_fract(rev);
            COS[(size_t)t * 32 + i] = __builtin_amdgcn_cosf(fr); SIN[(size_t)t * 32 + i] = __builtin_amdgcn_sinf(fr); }
    }
}

template <bool HAS_Y, int NOUT, bool XIN16, bool XOUT16>
DI void row_phase(Frame& F, const void* xin_, void* xout_, const bf16* y, const float* gy, const float* gate, int gstride,
                  const float* g0, const float* sh0, const float* sc0, int st0, bf16* out0,
                  const float* g1, const float* sh1, const float* sc1, int st1, bf16* out1) {
    const int gw = F.bid * NWAVES + F.wave, NGW = F.G * NWAVES, lane = F.lane;
    const int rpw = T / NGW, m0 = gw * rpw, b = m0 / S;
    f32x4 Gv[4], A0[4], B0[4], A1[4], B1[4];
#pragma unroll
    for (int j = 0; j < 4; ++j) { const int c = 4 * lane + 256 * j;
        if (HAS_Y) Gv[j] = *(const f32x4*)(gate + (size_t)b * gstride + c) * *(const f32x4*)(gy + c);
        if (NOUT > 0) { A0[j] = *(const f32x4*)(g0 + c) * (*(const f32x4*)(sc0 + (size_t)b * st0 + c) + 1.f); B0[j] = *(const f32x4*)(sh0 + (size_t)b * st0 + c); }
        if (NOUT > 1) { A1[j] = *(const f32x4*)(g1 + c) * (*(const f32x4*)(sc1 + (size_t)b * st1 + c) + 1.f); B1[j] = *(const f32x4*)(sh1 + (size_t)b * st1 + c); } }
    for (int rr = 0; rr < rpw; rr += 2) {
        f32x4 v[2][4], yv[2][4];
#pragma unroll
        for (int q = 0; q < 2; ++q) { const int m = m0 + rr + q;
#pragma unroll
            for (int j = 0; j < 4; ++j) {
                if (XIN16) { const v2u u = *(const v2u*)((const bf16*)xin_ + (size_t)m * D + 4 * lane + 256 * j); v[q][j] = (f32x4){bflo(u.x), bfhi(u.x), bflo(u.y), bfhi(u.y)}; }
                else v[q][j] = *(const f32x4*)((const float*)xin_ + (size_t)m * D + 4 * lane + 256 * j);
                if (HAS_Y) { const v2u u = *(const v2u*)(y + (size_t)m * D + 4 * lane + 256 * j); yv[q][j] = (f32x4){bflo(u.x), bfhi(u.x), bflo(u.y), bfhi(u.y)}; }
            } }
#pragma unroll
        for (int q = 0; q < 2; ++q) { const int m = m0 + rr + q;
            if (HAS_Y) {
                float ss = 0.f;
#pragma unroll
                for (int j = 0; j < 4; ++j) ss += (yv[q][j].x * yv[q][j].x + yv[q][j].y * yv[q][j].y) + (yv[q][j].z * yv[q][j].z + yv[q][j].w * yv[q][j].w);
                const float rinv = rsqrtf(wave_sum(ss) * (1.f / D) + EPS);
#pragma unroll
                for (int j = 0; j < 4; ++j) { const int c = 4 * lane + 256 * j;
                    v[q][j] = v[q][j] + Gv[j] * (yv[q][j] * rinv);
                    if (XOUT16) { v2u w; w.x = pk2(v[q][j].x, v[q][j].y); w.y = pk2(v[q][j].z, v[q][j].w); *(v2u*)((bf16*)xout_ + (size_t)m * D + c) = w;
                                  v[q][j] = (f32x4){bflo(w.x), bfhi(w.x), bflo(w.y), bfhi(w.y)}; }
                    else *(f32x4*)((float*)xout_ + (size_t)m * D + c) = v[q][j]; }
            }
            if (NOUT > 0) {
                float ss = 0.f;
#pragma unroll
                for (int j = 0; j < 4; ++j) ss += (v[q][j].x * v[q][j].x + v[q][j].y * v[q][j].y) + (v[q][j].z * v[q][j].z + v[q][j].w * v[q][j].w);
                const float rinv = rsqrtf(wave_sum(ss) * (1.f / D) + EPS);
#pragma unroll
                for (int j = 0; j < 4; ++j) { const int c = 4 * lane + 256 * j;
                    { const f32x4 o = v[q][j] * rinv * A0[j] + B0[j]; v2u w; w.x = pk2(o.x, o.y); w.y = pk2(o.z, o.w); *(v2u*)(out0 + (size_t)m * D + c) = w; }
                    if (NOUT > 1) { const f32x4 o = v[q][j] * rinv * A1[j] + B1[j]; v2u w; w.x = pk2(o.x, o.y); w.y = pk2(o.z, o.w); *(v2u*)(out1 + (size_t)m * D + c) = w; }
                }
            }
        }
    }
}
DI void latent_phase(Frame& F, const Args& a) {
    const bf16* KVA = (const bf16*)(a.ws + WS_KVA); const bf16* QA = (const bf16*)(a.ws + WS_QA);
    bf16* CKV = (bf16*)(a.ws + WS_CKV); bf16* KR = (bf16*)(a.ws + WS_KR); bf16* CQ = (bf16*)(a.ws + WS_CQ);
    const float* COS = (const float*)(a.ws + WS_COS); const float* SIN = (const float*)(a.ws + WS_SIN);
    const float* gl = a.in[14]; const float* gq = a.in[17];
    const int gw = F.bid * NWAVES + F.wave, NGW = F.G * NWAVES, lane = F.lane;
    const int rpw = T / NGW, m0 = gw * rpw;
    const f32x4 g = *(const f32x4*)(gl + 4 * lane);
    float gqv[6];
#pragma unroll
    for (int j = 0; j < 3; ++j) { gqv[2 * j] = gq[2 * lane + 128 * j]; gqv[2 * j + 1] = gq[2 * lane + 128 * j + 1]; }
#pragma unroll 2
    for (int rr = 0; rr < rpw; ++rr) { const int m = m0 + rr;
        const v2u u = *(const v2u*)(KVA + (size_t)m * 512 + 4 * lane);
        unsigned uq[3];
#pragma unroll
        for (int j = 0; j < 3; ++j) uq[j] = *(const unsigned*)(QA + (size_t)m * 512 + 2 * lane + 128 * j);
        float x1 = 0.f, x2 = 0.f, c = 0.f, s = 0.f;
        if (lane < 32) { x1 = bf2f((short)KVA[(size_t)m * 512 + 256 + lane]); x2 = bf2f((short)KVA[(size_t)m * 512 + 288 + lane]); c = COS[(size_t)m * 32 + lane]; s = SIN[(size_t)m * 32 + lane]; }
        { const f32x4 v = {bflo(u.x), bfhi(u.x), bflo(u.y), bfhi(u.y)};
          const float rinv = rsqrtf(wave_sum((v.x * v.x + v.y * v.y) + (v.z * v.z + v.w * v.w)) * (1.f / 256.f) + EPS);
          const f32x4 o = v * rinv * g; v2u w; w.x = pk2(o.x, o.y); w.y = pk2(o.z, o.w); *(v2u*)(CKV + (size_t)m * 256 + 4 * lane) = w; }
        if (lane < 32) { const unsigned o1 = pk2(x1 * c - x2 * s, 0.f), o2 = pk2(x2 * c + x1 * s, 0.f);
          KR[(size_t)m * 64 + lane] = (bf16)(o1 & 0xffffu); KR[(size_t)m * 64 + 32 + lane] = (bf16)(o2 & 0xffffu); }
        { float vv[6]; float ss = 0.f;
#pragma unroll
          for (int j = 0; j < 3; ++j) { vv[2 * j] = bflo(uq[j]); vv[2 * j + 1] = bfhi(uq[j]); ss += vv[2 * j] * vv[2 * j] + vv[2 * j + 1] * vv[2 * j + 1]; }
          const float rinv = rsqrtf(wave_sum(ss) * (1.f / 384.f) + EPS);
#pragma unroll
          for (int j = 0; j < 3; ++j) *(unsigned*)(CQ + (size_t)m * 384 + 2 * lane + 128 * j) = pk2(vv[2 * j] * rinv * gqv[2 * j], vv[2 * j + 1] * rinv * gqv[2 * j + 1]); }
    }
}

DI int ml_unit(int u) { const int h = u & 7, cc = u >> 3; return (((cc >> 6) * 8 + h) << 6) | (cc & 63); }
DI void mlstm_a(Frame& F, const Args& a) {
    LAS unsigned char* lds = F.lds;
    LAS float* a_l = (LAS float*)lds;
    LAS float* w_l = (LAS float*)(lds + 512);
    LAS unsigned char* KT = lds + 1024;
    LAS unsigned char* VT = lds + 1024 + 64 * 272;
    const bf16* P = (const bf16*)(a.ws + WS_P); const bf16* VTA = (const bf16*)(a.ws + WS_VTA); const float* G = (const float*)(a.ws + WS_G);
    float* AARR = (float*)(a.ws + WS_AARR); float* BARR = (float*)(a.ws + WS_BARR); float* CMARR = (float*)(a.ws + WS_CMARR);
    float* AMAX = (float*)(a.ws + WS_AMAX); float* BL = (float*)(a.ws + WS_BL);
    float* CST = (float*)(a.ws + WS_CST); float* DN = (float*)(a.ws + WS_DN);
    const float* gb = a.in[7];
    const int tid = F.tid, lane = F.lane, w = F.wave, r = lane & 31, hl = lane >> 5;
    v4u rk[2], rv[4]; float gi0 = 0.f, gi1 = 0.f, gf0 = 0.f, gf1 = 0.f;
#define MA_LOAD(ci_) do { const int bh_ = (ci_) >> 6, c_ = (ci_) & 63, b_ = bh_ >> 3, h_ = bh_ & 7, t0_ = b_ * S + c_ * 128; const int s_ = tid & 127; \
        _Pragma("unroll") for (int i = 0; i < 2; ++i) rk[i] = *(const v4u*)(P + (size_t)(t0_ + s_) * 2048 + 512 + h_ * 64 + 8 * ((tid >> 7) + 4 * i)); \
        _Pragma("unroll") for (int i = 0; i < 4; ++i) { const int cix = tid + 512 * i; rv[i] = *(const v4u*)(VTA + (size_t)(h_ * 128 + (cix >> 4)) * T + t0_ + 8 * (cix & 15)); } \
        if (w == 0) { gi0 = G[(size_t)(t0_ + lane) * 16 + h_]; gi1 = G[(size_t)(t0_ + 64 + lane) * 16 + h_]; gf0 = G[(size_t)(t0_ + lane) * 16 + 8 + h_]; gf1 = G[(size_t)(t0_ + 64 + lane) * 16 + 8 + h_]; } } while (0)
    if (F.bid < 2048) MA_LOAD(ml_unit(F.bid));
    for (int un = F.bid; un < 2048; un += F.G) {
        const int ci = ml_unit(un);
        const int bh = ci >> 6, c = ci & 63, h = bh & 7;
        __syncthreads();
        if (w == 0) {
            float ig0, ig1, lf0, lf1;
            { const float f = gf0 + gb[8 + h]; lf0 = fminf(f, 0.f) - log1pf(__expf(-fabsf(f))); ig0 = gi0 + gb[h]; }
            { const float f = gf1 + gb[8 + h]; lf1 = fminf(f, 0.f) - log1pf(__expf(-fabsf(f))); ig1 = gi1 + gb[h]; }
            float b0 = lf0, b1 = lf1;
#pragma unroll
            for (int o = 1; o < 64; o <<= 1) { const float u0 = __shfl_up(b0, o), u1 = __shfl_up(b1, o); if (lane >= o) { b0 += u0; b1 += u1; } }
            b1 += __shfl(b0, 63);
            const float a0 = ig0 - b0, a1 = ig1 - b1;
            float m0 = a0, m1 = a1;
#pragma unroll
            for (int o = 1; o < 64; o <<= 1) { const float u0 = __shfl_up(m0, o), u1 = __shfl_up(m1, o); if (lane >= o) { m0 = fmaxf(m0, u0); m1 = fmaxf(m1, u1); } }
            m1 = fmaxf(m1, __shfl(m0, 63));
            const float amax = __shfl(m1, 63), bl = __shfl(b1, 63);
            a_l[lane] = a0; a_l[64 + lane] = a1; w_l[lane] = 0.125f * __expf(a0 - amax); w_l[64 + lane] = 0.125f * __expf(a1 - amax);
            const size_t o = (size_t)bh * S + c * 128 + lane;
            AARR[o] = a0; AARR[o + 64] = a1; BARR[o] = b0; BARR[o + 64] = b1; CMARR[o] = m0; CMARR[o + 64] = m1;
            if (lane == 0) { AMAX[ci] = amax; BL[ci] = bl; }
        }
        __syncthreads();
        { const int s = tid & 127; const float ws = w_l[s];
#pragma unroll
          for (int i = 0; i < 2; ++i) { const int ch = (tid >> 7) + 4 * i; const v4u u = rk[i];
            const unsigned uu[4] = {u.x, u.y, u.z, u.w};
#pragma unroll
            for (int j = 0; j < 4; ++j) { const unsigned pr = pk2(bflo(uu[j]) * ws, bfhi(uu[j]) * ws);
                *(LAS unsigned short*)(KT + (8 * ch + 2 * j) * 272 + 2 * s) = (unsigned short)(pr & 0xffffu);
                *(LAS unsigned short*)(KT + (8 * ch + 2 * j + 1) * 272 + 2 * s) = (unsigned short)(pr >> 16); } } }
#pragma unroll
        for (int i = 0; i < 4; ++i) { const int cix = tid + 512 * i, e = cix >> 4, c16 = cix & 15; *(LAS v4u*)(VT + e * 272 + 16 * c16) = rv[i]; }
        if (un + F.G < 2048) MA_LOAD(ml_unit(un + F.G));
        __syncthreads();
        { const int eb = w & 3, db = w >> 2; f32x16 acc;
#pragma unroll
          for (int i = 0; i < 16; ++i) acc[i] = 0.f;
#pragma unroll
          for (int ks = 0; ks < 8; ++ks) { const bf16x8 av = *(const LAS bf16x8*)(VT + (32 * eb + r) * 272 + 32 * ks + 16 * hl);
              const bf16x8 bv = *(const LAS bf16x8*)(KT + (32 * db + r) * 272 + 32 * ks + 16 * hl); acc = MFMA32(av, bv, acc); }
          float* cp = CST + (size_t)ci * 8192;
#pragma unroll
          for (int i = 0; i < 16; ++i) cp[(32 * eb + crow(i, hl)) * 64 + 32 * db + r] = acc[i];
        }
        if (tid < 64) { float s = 0.f;
#pragma unroll
            for (int j = 0; j < 16; ++j) { const bf16x8 v = *(const LAS bf16x8*)(KT + tid * 272 + 16 * j);
#pragma unroll
                for (int q = 0; q < 8; ++q) s += bf2f(v[q]); }
            DN[(size_t)ci * 64 + tid] = s; }
    }
#undef MA_LOAD
}
DI void mlstm_b(Frame& F, const Args& a) {
    const float* AMAX = (const float*)(a.ws + WS_AMAX); const float* BL = (const float*)(a.ws + WS_BL); float* MPREV = (float*)(a.ws + WS_MPREV);
    const float* CST = (const float*)(a.ws + WS_CST); const float* DN = (const float*)(a.ws + WS_DN);
    unsigned* CIN = (unsigned*)(a.ws + WS_CIN); float* NIN = (float*)(a.ws + WS_NIN);
    for (int g = F.bid * NTHR + F.tid; g < 32 * 4096; g += F.G * NTHR) {
        const int bh = g >> 12, e2 = g & 4095;
        float c0 = 0.f, c1 = 0.f, m = 0.f, n0 = 0.f, n1 = 0.f;
#pragma unroll 1
        for (int cb = 0; cb < 64; cb += 16) {
            f32x2 d[16], dn[16]; float A[16], bl[16];
#pragma unroll
            for (int j = 0; j < 16; ++j) { const int ci = bh * 64 + cb + j; d[j] = *(const f32x2*)(CST + (size_t)ci * 8192 + 2 * e2); A[j] = AMAX[ci]; bl[j] = BL[ci];
                dn[j] = (e2 < 32) ? *(const f32x2*)(DN + (size_t)ci * 64 + 2 * e2) : (f32x2){0.f, 0.f}; }
#pragma unroll
            for (int j = 0; j < 16; ++j) { const int ci = bh * 64 + cb + j;
                CIN[(size_t)ci * 4096 + e2] = pk2(c0, c1);
                if (e2 < 32) { NIN[(size_t)ci * 64 + 2 * e2] = n0; NIN[(size_t)ci * 64 + 2 * e2 + 1] = n1; }
                if (e2 == 0) MPREV[ci] = m;
                const float M = fmaxf(m, A[j]), dec = __expf(m - M), sc = __expf(A[j] - M);
                c0 = dec * c0 + sc * d[j].x; c1 = dec * c1 + sc * d[j].y;
                n0 = dec * n0 + sc * dn[j].x; n1 = dec * n1 + sc * dn[j].y;
                m = bl[j] + M; }
        }
    }
}
DI void mlstm_c(Frame& F, const Args& a) {
    LAS unsigned char* lds = F.lds;
    LAS float* a_l = (LAS float*)lds;
    LAS float* n_l = (LAS float*)(lds + 512);
    LAS float* ssq = (LAS float*)(lds + 1024);
    LAS unsigned char* Qt = lds + 2048;
    LAS unsigned char* Kt = Qt + 128 * 144;
    LAS unsigned char* CT = Kt + 128 * 144;
    LAS unsigned char* VT = CT + 128 * 144;
    LAS unsigned char* OG = VT + 128 * 264;
    LAS float* HG = (LAS float*)(OG + 128 * 272);
    const bf16* P = (const bf16*)(a.ws + WS_P); const bf16* VTA = (const bf16*)(a.ws + WS_VTA);
    const float* AARR = (const float*)(a.ws + WS_AARR); const float* BARR = (const float*)(a.ws + WS_BARR); const float* CMARR = (const float*)(a.ws + WS_CMARR);
    const float* MPREV = (const float*)(a.ws + WS_MPREV); const bf16* CIN = (const bf16*)(a.ws + WS_CIN); const float* NIN = (const float*)(a.ws + WS_NIN);
    bf16* HM = (bf16*)(a.ws + WS_H); const float* hg = a.in[8];
    const int tid = F.tid, lane = F.lane, w = F.wave, r = lane & 31, hl = lane >> 5;
    for (int i = F.tid; i < 1024; i += NTHR) HG[i] = hg[i];
    const int tbw = (w < 4) ? w : 7 - w;
    v4u rq[2], rkk[2], rc[2], rvv[4], rog[4]; float rsm = 0.f, rmp = 0.f, rcm = 0.f, rbt = 0.f;
#define MC_LOAD(ci_) do { const int bh_ = (ci_) >> 6, c_ = (ci_) & 63, b_ = bh_ >> 3, h_ = bh_ & 7, t0_ = b_ * S + c_ * 128; \
        _Pragma("unroll") for (int i = 0; i < 2; ++i) { const int cix = tid + 512 * i, row = cix >> 3, c8 = cix & 7; \
            rq[i] = *(const v4u*)(P + (size_t)(t0_ + row) * 2048 + h_ * 64 + 8 * c8); rkk[i] = *(const v4u*)(P + (size_t)(t0_ + row) * 2048 + 512 + h_ * 64 + 8 * c8); \
            rc[i] = *(const v4u*)(CIN + (size_t)(ci_) * 8192 + row * 64 + 8 * c8); } \
        _Pragma("unroll") for (int i = 0; i < 4; ++i) { const int cix = tid + 512 * i; rvv[i] = *(const v4u*)(VTA + (size_t)(h_ * 128 + (cix >> 4)) * T + t0_ + 8 * (cix & 15)); } \
        _Pragma("unroll") for (int i = 0; i < 4; ++i) { const int cix = tid + 512 * i; rog[i] = *(const v4u*)(P + (size_t)(t0_ + (cix >> 4)) * 2048 + 1024 + h_ * 128 + 8 * (cix & 15)); } \
        if (tid < 128) rsm = AARR[(size_t)bh_ * S + c_ * 128 + tid]; else if (tid < 192) rsm = NIN[(size_t)(ci_) * 64 + tid - 128]; \
        rmp = MPREV[(ci_)]; rcm = CMARR[(size_t)bh_ * S + c_ * 128 + 32 * tbw + r]; rbt = BARR[(size_t)bh_ * S + c_ * 128 + 32 * tbw + r]; } while (0)
    if (F.bid < 2048) MC_LOAD(ml_unit(F.bid));
    for (int un = F.bid; un < 2048; un += F.G) {
        const int ci = ml_unit(un);
        const int bh = ci >> 6, c = ci & 63, b = bh >> 3, h = bh & 7, t0 = b * S + c * 128;
        __syncthreads();
        if (tid < 128) a_l[tid] = rsm;
        else if (tid < 192) n_l[tid - 128] = rsm;
#pragma unroll
        for (int i = 0; i < 2; ++i) { const int cix = tid + 512 * i, row = cix >> 3, c8 = cix & 7;
            *(LAS v4u*)(Qt + row * 144 + 16 * c8) = rq[i]; *(LAS v4u*)(Kt + row * 144 + 16 * c8) = rkk[i]; *(LAS v4u*)(CT + row * 144 + 16 * c8) = rc[i]; }
#pragma unroll
        for (int i = 0; i < 4; ++i) { const int cix = tid + 512 * i, e = cix >> 4, c16 = cix & 15; const v4u u = rvv[i];
            *(LAS v2u*)(VT + e * 264 + 16 * c16) = (v2u){u.x, u.y}; *(LAS v2u*)(VT + e * 264 + 16 * c16 + 8) = (v2u){u.z, u.w};
            *(LAS v4u*)(OG + e * 272 + 16 * c16) = rog[i]; }
        __syncthreads();
        const float mprev = rmp, cm_t = rcm, bt = rbt;
        if (un + F.G < 2048) MC_LOAD(ml_unit(un + F.G));
        const int tb = tbw, eh = w >> 2, tl = 32 * tb + r;
        bf16x8 qf[4];
#pragma unroll
        for (int kk = 0; kk < 4; ++kk) qf[kk] = *(const LAS bf16x8*)(Qt + tl * 144 + 32 * kk + 16 * hl);
        f32x16 acc[2];
#pragma unroll
        for (int eb = 0; eb < 2; ++eb) {
#pragma unroll
            for (int i = 0; i < 16; ++i) acc[eb][i] = 0.f;
#pragma unroll
            for (int kk = 0; kk < 4; ++kk) { const bf16x8 cv = *(const LAS bf16x8*)(CT + (64 * eh + 32 * eb + r) * 144 + 32 * kk + 16 * hl); acc[eb] = MFMA32(cv, qf[kk], acc[eb]); } }
        float qn = 0.f;
#pragma unroll
        for (int kk = 0; kk < 4; ++kk)
#pragma unroll
            for (int j = 0; j < 8; ++j) qn += bf2f(qf[kk][j]) * n_l[16 * kk + 8 * hl + j];
        qn += __shfl_xor(qn, 32);
        const float Mt = fmaxf(mprev, cm_t);
        const float winter = __expf(mprev - Mt);
#pragma unroll
        for (int eb = 0; eb < 2; ++eb)
#pragma unroll
            for (int i = 0; i < 16; ++i) acc[eb][i] *= winter;
        float den = 0.f;
        for (int sb = 0; sb <= tb; ++sb) {
            f32x16 st;
#pragma unroll
            for (int i = 0; i < 16; ++i) st[i] = 0.f;
#pragma unroll
            for (int kk = 0; kk < 4; ++kk) { const bf16x8 kv = *(const LAS bf16x8*)(Kt + (32 * sb + r) * 144 + 32 * kk + 16 * hl); st = MFMA32(kv, qf[kk], st); }
#pragma unroll
            for (int g = 0; g < 4; ++g) { const f32x4 av = *(const LAS f32x4*)(a_l + 32 * sb + 8 * g + 4 * hl);
#pragma unroll
                for (int j = 0; j < 4; ++j) { const int i = 4 * g + j, s = 32 * sb + 8 * g + 4 * hl + j; const float e = __builtin_amdgcn_exp2f((av[j] - Mt) * 1.4426950408889634f);
                    const float p = (s <= tl) ? st[i] * 0.125f * e : 0.f; den += p; st[i] = p; } }
#pragma unroll
            for (int ks = 0; ks < 2; ++ks) { const bf16x8 pf = pack8(st[8 * ks], st[8 * ks + 1], st[8 * ks + 2], st[8 * ks + 3], st[8 * ks + 4], st[8 * ks + 5], st[8 * ks + 6], st[8 * ks + 7]);
#pragma unroll
                for (int eb = 0; eb < 2; ++eb) { const LAS unsigned char* vp = VT + (64 * eh + 32 * eb + r) * 264 + (32 * sb + 16 * ks + 4 * hl) * 2;
                    const s16x4 lo = *(const LAS s16x4*)vp, hi = *(const LAS s16x4*)(vp + 16);
                    const bf16x8 vf = __builtin_shufflevector(lo, hi, 0, 1, 2, 3, 4, 5, 6, 7); acc[eb] = MFMA32(vf, pf, acc[eb]); } }
        }
        den += __shfl_xor(den, 32);
        const float dtot = winter * qn + den;
        const float dinv = __builtin_amdgcn_rcpf(fmaxf(fabsf(dtot), __expf(-(bt + Mt))));
        float sq = 0.f;
#pragma unroll
        for (int eb = 0; eb < 2; ++eb)
#pragma unroll
            for (int i = 0; i < 16; ++i) { acc[eb][i] *= dinv; sq += acc[eb][i] * acc[eb][i]; }
        sq += __shfl_xor(sq, 32);
        if (hl == 0) ssq[eh * 128 + tl] = sq;
        __syncthreads();
        const float rinv = rsqrtf((ssq[tl] + ssq[128 + tl]) * (1.f / 128.f) + EPS);
#pragma unroll
        for (int eb = 0; eb < 2; ++eb)
#pragma unroll
            for (int g = 0; g < 4; ++g) { const int e = 64 * eh + 32 * eb + 8 * g + 4 * hl;
                const v2u ou = *(const LAS v2u*)(OG + tl * 272 + 2 * e); const f32x4 gg = *(const LAS f32x4*)(HG + h * 128 + e);
                const float o0 = bflo(ou.x), o1 = bfhi(ou.x), o2 = bflo(ou.y), o3 = bfhi(ou.y);
                const float y0 = acc[eb][4 * g] * rinv * gg.x * __builtin_amdgcn_rcpf(1.f + __expf(-o0)), y1 = acc[eb][4 * g + 1] * rinv * gg.y * __builtin_amdgcn_rcpf(1.f + __expf(-o1));
                const float y2 = acc[eb][4 * g + 2] * rinv * gg.z * __builtin_amdgcn_rcpf(1.f + __expf(-o2)), y3 = acc[eb][4 * g + 3] * rinv * gg.w * __builtin_amdgcn_rcpf(1.f + __expf(-o3));
                v2u wv; wv.x = pk2(y0, y1); wv.y = pk2(y2, y3); *(LAS v2u*)(Qt + tl * 272 + 2 * e) = wv; }
        __syncthreads();
#pragma unroll
        for (int i = 0; i < 4; ++i) { const int cix = tid + 512 * i, row = cix >> 4, c16 = cix & 15;
            *(v4u*)(HM + (size_t)(t0 + row) * 1024 + h * 128 + 8 * c16) = *(const LAS v4u*)(Qt + row * 272 + 16 * c16); }
    }
#undef MC_LOAD
}

constexpr int AT_KROW = 400, AT_VROW = 144, AT_KSLOT = 64 * AT_KROW, AT_VSLOT = 128 * AT_VROW, AT_VBASE = 2 * AT_KSLOT;
static_assert(AT_VBASE + 3 * AT_VSLOT <= 131072, "attention LDS rings");
#define AT_FENCE() __builtin_amdgcn_sched_barrier(0)
DI void at_qk(const LAS unsigned char* kp, const bf16x8 (&qf)[12], f32x16& st) {
    bf16x8 kf[6];
#pragma unroll
    for (int j = 0; j < 6; ++j) kf[j] = *(const LAS bf16x8*)(kp + 32 * j);
    AT_FENCE();
#pragma unroll
    for (int i = 0; i < 16; ++i) st[i] = 0.f;
#pragma unroll
    for (int kk = 0; kk < 12; ++kk) { st = MFMA32(kf[kk % 6], qf[kk], st); if (kk + 6 < 12) { kf[kk % 6] = *(const LAS bf16x8*)(kp + 32 * (kk + 6)); AT_FENCE(); } }
}
DI void at_block(const LAS unsigned char* kp, const LAS unsigned char* vp, const bool diag, const int dd, const bf16x8 (&qf)[12],
                 float& m_run, float& l_run, f32x16 (&acc)[4], bf16x8& pf0, bf16x8& pf1, const LAS unsigned char*& vprev) {
    constexpr float SCL = 0.07216878364870322f * 1.4426950408889634f;
    bf16x8 vf[4];
    f32x16 st;
    at_qk(kp, qf, st);
#pragma unroll
    for (int eb = 0; eb < 4; ++eb) vf[eb] = *(const LAS bf16x8*)(vprev + 32 * eb * AT_VROW);
    if (diag) {
        asm volatile("" ::: "memory");
#pragma unroll
        for (int i = 0; i < 16; ++i) { const int cr = (i & 3) + 8 * (i >> 2); if (cr > dd) st[i] = -1e30f; }
    }
    float mx = fmaxf(st[0], st[1]);
#pragma unroll
    for (int i = 2; i < 16; ++i) mx = fmaxf(mx, st[i]);
    constexpr float AT_THR = 8.0f;
    const float mc = mx * SCL;
    const bool resc = __builtin_amdgcn_ballot_w64(mc > m_run + AT_THR) != 0ull;
    float alpha = 1.0f;
    if (resc) { const float mfull = fmaxf(mc, __shfl_xor(mc, 32));
                const float m_new = fmaxf(m_run, mfull);
                alpha = __builtin_amdgcn_exp2f(m_run - m_new); l_run *= alpha; m_run = m_new; }
    const float nm = -m_run;
#define AT_EXP(i_) do { const float p_ = __builtin_amdgcn_exp2f(__builtin_fmaf(st[(i_)], SCL, nm)); l_run += p_; st[(i_)] = p_; } while (0)
    AT_FENCE();
#pragma unroll
    for (int eb = 0; eb < 4; ++eb) { acc[eb] = MFMA32(vf[eb], pf0, acc[eb]); vf[eb] = *(const LAS bf16x8*)(vprev + 32 * eb * AT_VROW + 32); AT_EXP(2 * eb); AT_EXP(2 * eb + 1); AT_FENCE(); }
#pragma unroll
    for (int eb = 0; eb < 4; ++eb) { acc[eb] = MFMA32(vf[eb], pf1, acc[eb]); AT_EXP(8 + 2 * eb); AT_EXP(9 + 2 * eb); AT_FENCE(); }
#undef AT_EXP
    if (resc) {
        asm volatile("" ::: "memory");
#pragma unroll
        for (int eb = 0; eb < 4; ++eb)
#pragma unroll
            for (int i = 0; i < 16; ++i) acc[eb][i] *= alpha;
    }
    pf0 = pack8(st[0], st[1], st[2], st[3], st[4], st[5], st[6], st[7]);
    pf1 = pack8(st[8], st[9], st[10], st[11], st[12], st[13], st[14], st[15]);
    vprev = vp;
}
DI void attn_unit(Frame& F, const Args& a, int b, int h, int qb) {
    LAS unsigned char* lds = F.lds;
    const bf16* Q = (const bf16*)(a.ws + WS_Q); const bf16* KN = (const bf16*)(a.ws + WS_KN); const bf16* KR = (const bf16*)(a.ws + WS_KR); const bf16* VTB = (const bf16*)(a.ws + WS_VTB);
    const float* COS = (const float*)(a.ws + WS_COS); const float* SIN = (const float*)(a.ws + WS_SIN); bf16* O = (bf16*)(a.ws + WS_O);
    int tid_ = F.tid; asm volatile("" : "+v"(tid_));
    const int tid = tid_, lane = tid & 63, w = F.wave, r = lane & 31, hl = lane >> 5;
    const int q0 = qb * 256, qpos = q0 + 32 * w + r, tq = b * S + qpos;
    bf16x8 qf[12];
    { const bf16* qrow = Q + (size_t)tq * 1536 + h * 192 + 8 * hl;
#pragma unroll
      for (int kk = 0; kk < 8; ++kk) qf[kk] = *(const bf16x8*)(qrow + 16 * kk);
#pragma unroll
      for (int p = 0; p < 2; ++p) { const bf16x8 x1 = *(const bf16x8*)(qrow + 128 + 16 * p), x2 = *(const bf16x8*)(qrow + 160 + 16 * p);
        const float* cp = COS + (size_t)tq * 32 + 16 * p + 8 * hl; const float* sp = SIN + (size_t)tq * 32 + 16 * p + 8 * hl;
        const f32x4 c0 = *(const f32x4*)cp, c1 = *(const f32x4*)(cp + 4), s0 = *(const f32x4*)sp, s1 = *(const f32x4*)(sp + 4);
        float o1[8], o2[8];
#pragma unroll
        for (int j = 0; j < 8; ++j) { const float u1 = bf2f(x1[j]), u2 = bf2f(x2[j]); const float cc = j < 4 ? c0[j & 3] : c1[j & 3], sn = j < 4 ? s0[j & 3] : s1[j & 3];
            o1[j] = u1 * cc - u2 * sn; o2[j] = u2 * cc + u1 * sn; }
        qf[8 + p] = pack8(o1[0], o1[1], o1[2], o1[3], o1[4], o1[5], o1[6], o1[7]); qf[10 + p] = pack8(o2[0], o2[1], o2[2], o2[3], o2[4], o2[5], o2[6], o2[7]); } }
    f32x16 acc[4];
#pragma unroll
    for (int eb = 0; eb < 4; ++eb)
#pragma unroll
        for (int i = 0; i < 16; ++i) acc[eb][i] = 0.f;
    float m_run = -1e30f, l_run = 0.f;
    const int nt = (qb + 1) * 4;
    const unsigned kn_off = (unsigned)((b * S + (tid >> 4)) * 1024 + h * 128 + 8 * (tid & 15));
    const unsigned kr_off = (unsigned)((b * S + (tid >> 3)) * 64 + 8 * (tid & 7));
    const unsigned vt_off = (unsigned)((h * 128 + (tid >> 3)) * T + b * S + 8 * (tid & 7));
    const int kn_dst = (tid >> 4) * AT_KROW + 16 * (tid & 15), kr_dst = (tid >> 3) * AT_KROW + 256 + 16 * (tid & 7);
    const int vt_dst = AT_VBASE + (tid >> 3) * AT_VROW + 32 * ((tid & 7) >> 1) + 8 * (tid & 1);
    v4u rk0, rk1, rr, rv0, rv1;
#define AT_LOADK(key0) do { rk0 = *(const v4u*)(KN + (kn_off + (unsigned)(key0) * 1024u)); rk1 = *(const v4u*)(KN + (kn_off + (unsigned)((key0) + 32) * 1024u)); rr = *(const v4u*)(KR + (kr_off + (unsigned)(key0) * 64u)); } while (0)
#define AT_LOADV(key0) do { rv0 = *(const v4u*)(VTB + (vt_off + (unsigned)(key0))); rv1 = *(const v4u*)(VTB + (vt_off + 64u * (unsigned)T + (unsigned)(key0))); } while (0)
#define AT_STOREK(ks_) do { LAS unsigned char* kb_ = lds + (ks_) * AT_KSLOT; *(LAS v4u*)(kb_ + kn_dst) = rk0; *(LAS v4u*)(kb_ + kn_dst + 32 * AT_KROW) = rk1; *(LAS v4u*)(kb_ + kr_dst) = rr; } while (0)
#define AT_STOREV(vs_) do { LAS unsigned char* vb_ = lds + (vs_) * AT_VSLOT; *(LAS v2u*)(vb_ + vt_dst) = (v2u){rv0.x, rv0.y}; *(LAS v2u*)(vb_ + vt_dst + 16) = (v2u){rv0.z, rv0.w}; \
        *(LAS v2u*)(vb_ + vt_dst + 64 * AT_VROW) = (v2u){rv1.x, rv1.y}; *(LAS v2u*)(vb_ + vt_dst + 64 * AT_VROW + 16) = (v2u){rv1.z, rv1.w}; } while (0)
    AT_LOADK(0); AT_LOADV(0); AT_STOREK(0); AT_STOREV(0);
    __syncthreads();
    const int koff = r * AT_KROW + 16 * hl, voff = AT_VBASE + r * AT_VROW + 16 * hl;
    bf16x8 pf0, pf1; const LAS unsigned char* vprev = lds + voff;
#pragma unroll
    for (int j = 0; j < 8; ++j) { pf0[j] = 0; pf1[j] = 0; }
    int vs = 0;
    for (int kt = 0; kt < nt; ++kt) {
        const int key0 = kt * 64;
        const int vsn = (vs == 2) ? 0 : vs + 1;
        if (kt + 1 < nt) AT_LOADK(key0 + 64);
        const LAS unsigned char* Kc = lds + (kt & 1) * AT_KSLOT + koff; const LAS unsigned char* Vc = lds + vs * AT_VSLOT + voff;
        const bool diag = (key0 + 63 > q0 + 32 * w);
        const int dd = qpos - key0 - 4 * hl;
        at_block(Kc, Vc, diag, dd, qf, m_run, l_run, acc, pf0, pf1, vprev);
        if (kt + 1 < nt) { AT_STOREK((kt + 1) & 1); AT_LOADV(key0 + 64); }
        at_block(Kc + 32 * AT_KROW, Vc + 64, diag, dd - 32, qf, m_run, l_run, acc, pf0, pf1, vprev);
        if (kt + 1 < nt) AT_STOREV(vsn);
        __syncthreads();
        vs = vsn;
    }
#undef AT_LOADK
#undef AT_LOADV
#undef AT_STOREK
#undef AT_STOREV
    {
        bf16x8 vf[4];
#pragma unroll
        for (int eb = 0; eb < 4; ++eb) vf[eb] = *(const LAS bf16x8*)(vprev + 32 * eb * AT_VROW);
#pragma unroll
        for (int eb = 0; eb < 4; ++eb) { acc[eb] = MFMA32(vf[eb], pf0, acc[eb]); vf[eb] = *(const LAS bf16x8*)(vprev + 32 * eb * AT_VROW + 32); }
#pragma unroll
        for (int eb = 0; eb < 4; ++eb) acc[eb] = MFMA32(vf[eb], pf1, acc[eb]);
    }
    const float linv = 1.f / (l_run + __shfl_xor(l_run, 32));
    int tid2 = F.tid; asm volatile("" : "+v"(tid2));
    const int r2 = tid2 & 31, hl2 = (tid2 >> 5) & 1;
    bf16* orow = (bf16*)(a.ws + WS_O) + (size_t)(b * S + qb * 256 + 32 * w + r2) * 1024 + h * 128;
#pragma unroll
    for (int eb = 0; eb < 4; ++eb)
#pragma unroll
        for (int g = 0; g < 4; ++g) { v2u wv; wv.x = pk2(acc[eb][4 * g] * linv, acc[eb][4 * g + 1] * linv); wv.y = pk2(acc[eb][4 * g + 2] * linv, acc[eb][4 * g + 3] * linv);
            *(v2u*)(orow + 32 * eb + 8 * g + 4 * hl2) = wv; }
    __syncthreads();
}
DI void attn_phase(Frame& F, const Args& a) {
    for (int wg = F.bid; wg < 256; wg += F.G) {
        const int bh = wg & 31, g = wg >> 5, b = bh >> 3, h = bh & 7;
#pragma unroll 1
        for (int i = 0; i < 4; ++i) { const int qb = (i == 0) ? 31 - g : (i == 1) ? 23 - g : (i == 2) ? 8 + g : g; attn_unit(F, a, b, h, qb); }
    }
}

template <class Epi> DI void run_gemm(Frame& F, const bf16* A, const bf16* Bt, int M, int N, int K, const Epi& E) {
    pg8::Gemm g{A, Bt, M, N, K}; pg8::StaticOrder So; So.init(M, N, F.G, F.bid);
    pg8::gemm_phase<Epi, pg8::StaticOrder, PG8_ALIGN, PG8_SP2>((PG8_LAS unsigned char*)F.lds, g, So, E);
}

__global__ void __launch_bounds__(NTHR, 2) yoco_fwd(Args args) {
    extern __shared__ __attribute__((aligned(16))) unsigned char lds_raw[];
    Frame F; F.lds = (LAS unsigned char*)lds_raw; F.tid = threadIdx.x; F.lane = F.tid & 63; F.wave = __builtin_amdgcn_readfirstlane(F.tid >> 6); F.G = gridDim.x; F.bid = blockIdx.x;
    unsigned char* ws = args.ws;
    const int lo = args.ph_lo, hi = args.ph_hi;
#define REFRESH() do { int t_ = threadIdx.x; asm volatile("" : "+v"(t_)); F.tid = t_; F.lane = t_ & 63; } while (0)
    volatile LAS unsigned* MISC = (volatile LAS unsigned*)(F.lds + MISC_OFF);
    if (F.tid < 32) MISC[F.tid] = 0u;
    __syncthreads();
    XcdBarrier bar = xcd_barrier_post((unsigned*)ws + CW_BAR, MISC + 8);
#define IN(k) (lo <= (k) && (k) < hi)
#if MK_MULTI
#define SEAM(k) do { } while (0)
#else
#define SEAM(k) do { if (IN(k) && IN((k) + 1)) { if ((k) == 0) cg::this_grid().sync(); else xcd_barrier(bar); } } while (0)
#endif
    const float* ADA0 = (const float*)(ws + WS_ADA); const float* ADA1 = ADA0 + 4 * 6144; const float* KVADA = ADA0 + 8 * 6144;
    const float* norm_g = args.in[5];
    bf16* H = (bf16*)(ws + WS_H); bf16* H2 = (bf16*)(ws + WS_H2); bf16* Y = (bf16*)(ws + WS_Y); bf16* U = (bf16*)(ws + WS_U);
    void* X = (void*)args.out;
    void* X3 = (void*)(ws + WS_H2);

    REFRESH();
    if (IN(0)) { p0_weights(F, args); p0_ada(F, args); p0_rope(F, args); }
    SEAM(0);
    REFRESH();
    if (IN(1)) row_phase<false, 1, false, false>(F, args.in[0], nullptr, nullptr, nullptr, nullptr, 0, norm_g + 0 * D, ADA0 + 0, ADA0 + 1024, 6144, H, nullptr, nullptr, nullptr, 0, nullptr);
    SEAM(1);
    REFRESH();
    if (IN(2)) {
        pg8::EpiProj E{(bf16*)(ws + WS_P), 2048, (float*)(ws + WS_G), 8};
        run_gemm(F, H, (const bf16*)(ws + W_IN), T, 2304, 1024, E);
        pg8::EpiOut<0> E2{(bf16*)(ws + WS_VTA), T};
        run_gemm(F, (const bf16*)(ws + W_V), H, 1024, T, 1024, E2);
    }
    SEAM(2);
    REFRESH();
    if (IN(3)) mlstm_a(F, args);
    SEAM(3);
    REFRESH();
    if (IN(4)) mlstm_b(F, args);
    SEAM(4);
    REFRESH();
    if (IN(5)) mlstm_c(F, args);
    SEAM(5);
    REFRESH();
    if (IN(6)) { pg8::EpiOut<0> E{Y, 1024}; run_gemm(F, H, (const bf16*)(ws + W_AO), T, 1024, 1024, E); }
    SEAM(6);
    REFRESH();
    if (IN(7)) row_phase<true, 1, false, true>(F, args.in[0], X, Y, norm_g + 1 * D, ADA0 + 2048, 6144, norm_g + 2 * D, ADA0 + 3072, ADA0 + 4096, 6144, H, nullptr, nullptr, nullptr, 0, nullptr);
    SEAM(7);
    REFRESH();
    if (IN(8)) { pg8::EpiOut<2> E{U, FF}; run_gemm(F, H, (const bf16*)(ws + W_1A), T, FF, 1024, E); }
    SEAM(8);
    REFRESH();
    if (IN(9)) { pg8::EpiOut<0> E{Y, 1024}; run_gemm(F, U, (const bf16*)(ws + W_2A), T, 1024, FF, E); }
    SEAM(9);
    REFRESH();
    if (IN(10)) row_phase<true, 2, true, true>(F, X, X, Y, norm_g + 3 * D, ADA0 + 5120, 6144, args.in[12], KVADA + 0, KVADA + 1024, 2048, H, norm_g + 4 * D, ADA1 + 0, ADA1 + 1024, 6144, H2);
    SEAM(10);
    REFRESH();
    if (IN(11)) {
        pg8::EpiOut<0> E{(bf16*)(ws + WS_KVA), 512}; run_gemm(F, H, (const bf16*)(ws + W_KVA), T, 512, 1024, E);
        pg8::EpiOut<0> E2{(bf16*)(ws + WS_QA), 512}; run_gemm(F, H2, (const bf16*)(ws + W_QA), T, 512, 1024, E2);
    }
    SEAM(11);
    REFRESH();
    if (IN(12)) latent_phase(F, args);
    SEAM(12);
    REFRESH();
    if (IN(13)) {
        pg8::EpiOut<0> E{(bf16*)(ws + WS_KN), 1024}; run_gemm(F, (const bf16*)(ws + WS_CKV), (const bf16*)(ws + W_BK), T, 1024, 256, E);
        pg8::EpiOut<0> E2{(bf16*)(ws + WS_VTB), T}; run_gemm(F, (const bf16*)(ws + W_BV), (const bf16*)(ws + WS_CKV), 1024, T, 256, E2);
        pg8::EpiOut<0> E3{(bf16*)(ws + WS_Q), 1536}; run_gemm(F, (const bf16*)(ws + WS_CQ), (const bf16*)(ws + W_QB), T, 1536, 384, E3);
    }
    SEAM(13);
    REFRESH();
    if (IN(14)) attn_phase(F, args);
    SEAM(14);
    REFRESH();
    if (IN(15)) { pg8::EpiOut<0> E{Y, 1024}; run_gemm(F, (const bf16*)(ws + WS_O), (const bf16*)(ws + W_BO), T, 1024, 1024, E); }
    SEAM(15);
    REFRESH();
    if (IN(16)) row_phase<true, 1, true, true>(F, X, X3, Y, norm_g + 5 * D, ADA1 + 2048, 6144, norm_g + 6 * D, ADA1 + 3072, ADA1 + 4096, 6144, H, nullptr, nullptr, nullptr, 0, nullptr);
    SEAM(16);
    REFRESH();
    if (IN(17)) { pg8::EpiOut<2> E{U, FF}; run_gemm(F, H, (const bf16*)(ws + W_1B), T, FF, 1024, E); }
    SEAM(17);
    REFRESH();
    if (IN(18)) { pg8::EpiOut<0> E{Y, 1024}; run_gemm(F, U, (const bf16*)(ws + W_2B), T, 1024, FF, E); }
    SEAM(18);
    REFRESH();
    if (IN(19)) row_phase<true, 0, true, false>(F, X3, args.out, Y, norm_g + 7 * D, ADA1 + 5120, 6144, nullptr, nullptr, nullptr, 0, nullptr, nullptr, nullptr, nullptr, 0, nullptr);
#undef IN
#undef SEAM
#undef REFRESH
}

extern "C" void kernel_launch(void* const* d_in, const int* in_sizes, int n_in, void* d_out, int out_size, void* d_ws, size_t ws_size, hipStream_t stream) {
    static int grid = 0;
    if (grid == 0) {
        if (n_in != 22 || in_sizes[0] != T * D || out_size != T * D || ws_size < WS_END) { fprintf(stderr, "kernel_launch: unexpected shapes (n_in %d, in0 %d, out %d, ws %zu)\n", n_in, n_in > 0 ? in_sizes[0] : -1, out_size, ws_size); grid = -1; return; }
        int dev = 0, cus = 0, per_cu = 0;
        (void)hipGetDevice(&dev); (void)hipDeviceGetAttribute(&cus, hipDeviceAttributeMultiprocessorCount, dev);
        if (hipFuncSetAttribute((const void*)yoco_fwd, hipFuncAttributeMaxDynamicSharedMemorySize, LDS_BYTES) != hipSuccess) { fprintf(stderr, "kernel_launch: hipFuncSetAttribute failed\n"); grid = -1; return; }
        if (hipOccupancyMaxActiveBlocksPerMultiprocessor(&per_cu, (const void*)yoco_fwd, NTHR, LDS_BYTES) != hipSuccess || per_cu < 1) { fprintf(stderr, "kernel_launch: occupancy query says %d\n", per_cu); per_cu = 1; }
        (void)hipGetLastError();
        grid = cus;
        if (grid > 256) grid = 256;
    }
    if (grid < 0) return;
    Args a; memset(&a, 0, sizeof(a));
    for (int i = 0; i < 22; ++i) a.in[i] = (const float*)d_in[i];
    a.out = (float*)d_out; a.ws = (unsigned char*)d_ws;
    for (int i = 0; i < 32; ++i) a.inv_freq[i] = powf(10000.0f, -(float)i / 32.0f);
#if MK_MULTI
    for (int p = 0; p < NPHASE; ++p) { a.ph_lo = p; a.ph_hi = p + 1; hipLaunchKernelGGL(yoco_fwd, dim3(grid), dim3(NTHR), LDS_BYTES, stream, a); }
#else
    a.ph_lo = 0; a.ph_hi = NPHASE;
    if (hipMemsetAsync(d_ws, 0, CTL_ZERO_BYTES, stream) != hipSuccess) { fprintf(stderr, "kernel_launch: memset failed\n"); return; }
    void* kargs[] = {&a};
    hipError_t e = hipLaunchCooperativeKernel((const void*)yoco_fwd, dim3(grid), dim3(NTHR), kargs, LDS_BYTES, stream);
    if (e != hipSuccess) fprintf(stderr, "kernel_launch: cooperative launch failed: %s (grid %d)\n", hipGetErrorString(e), grid);
#endif
}
```

```cpp
#include <hip/hip_runtime.h>
#include <hip/hip_cooperative_groups.h>
#include <cstdio>
#include <cstdint>
#include <cmath>
#include <cstring>
namespace cg = cooperative_groups;
namespace pg8 {
#define PG8_LAS __attribute__((address_space(3)))
typedef unsigned short bf16_t;
typedef short bf16x8 __attribute__((ext_vector_type(8)));
typedef float f32x4 __attribute__((ext_vector_type(4)));
typedef unsigned u32x4 __attribute__((ext_vector_type(4)));
constexpr int BM = 256, BK = 64, HALF = 128, HTB = HALF * BK * 2  , STAGE_BYTES = 8 * HTB, NXCD = 8, WGM = 8;

__host__ __device__ __forceinline__ int lds_byte(int r, int c) { const int st = (r >> 4) * 2 + (c >> 5), rr = r & 15, cc = c & 31, ob = rr * 64 + cc * 2; return st * 1024 + (ob ^ (((ob >> 9) & 1) << 5)); }
__host__ __device__ __forceinline__ void stage_rc(int b, int& R, int& C) { const int st = b / 1024, sb = b % 1024, swz = sb ^ (((sb >> 9) & 1) << 5); R = (st >> 1) * 16 + swz / 64; C = (st & 1) * 32 + (swz % 64) / 2; }
__host__ __device__ __forceinline__ int perm32(int rho) { const int n = rho >> 4, i = rho & 15; return 8 * (i >> 2) + 4 * n + (i & 3); }

struct Unit { int pm, pn; };
struct Gemm { const bf16_t* A; const bf16_t* Bt; int M, N, K; };

struct StaticOrder {
    int nM, nN, nwg, G, c;
    __host__ __device__ void init(int M, int N, int G_, int c_) { nM = M / BM; nN = N / BM; nwg = nM * nN; G = G_; c = c_; }
    __host__ __device__ bool next(int i, Unit& u) const {
        const long L = (long)i * G + c; if (L >= nwg) return false;
        int wgid = (int)L; { const int q = nwg / NXCD, r = nwg % NXCD, xcd = wgid % NXCD, off = wgid / NXCD; wgid = (xcd < r ? xcd * (q + 1) : r * (q + 1) + (xcd - r) * q) + off; }
        const int nig = WGM * nN, gid = wgid / nig, fm = gid * WGM, gsz = (nM - fm) < WGM ? (nM - fm) : WGM;
        u.pm = fm + ((wgid % nig) % gsz); u.pn = (wgid % nig) / gsz; return true;
    }
    __device__ __forceinline__ void a_ready(const Unit&) const {}
    __device__ __forceinline__ void done(const Unit&) const {}
};

__device__ __forceinline__ unsigned cvt_pk_bf16(float lo, float hi) { unsigned r; asm volatile("v_cvt_pk_bf16_f32 %0, %1, %2" : "=v"(r) : "v"(lo), "v"(hi)); return r; }
typedef float f32x2 __attribute__((ext_vector_type(2)));
__device__ __forceinline__ f32x2 gelu_pk(f32x2 v) {
    const f32x2 av = __builtin_elementwise_abs(v), d = av * 0.2316418882f + 1.0f;
    f32x2 t; t.x = __builtin_amdgcn_rcpf(d.x); t.y = __builtin_amdgcn_rcpf(d.y);
    f32x2 q = t * 0.5307027145f + (-0.7265760135f); q = q * t + 0.7107068705f; q = q * t + (-0.142248368f); q = q * t + 0.127414796f; q = q * t;
    const f32x2 s = (v * v) * (-0.72134752044f);
    f32x2 e; e.x = __builtin_amdgcn_exp2f(s.x); e.y = __builtin_amdgcn_exp2f(s.y);
    const f32x2 m = v * (q * e), r = v - m;
    f32x2 o; o.x = v.x < 0.f ? m.x : r.x; o.y = v.y < 0.f ? m.y : r.y; return o;
}

template <int ACT  > struct EpiBf16 {
    static constexpr bool PERM = true, AFTER_DRAIN = false; static_assert(ACT == 0 || ACT == 1, "EpiBf16: ACT is 0 (none) or 1 (gelu_pk)");
    bf16_t* O; int ldc; const float* bias; int split_cols; size_t split_stride; float scale0;
    __device__ __forceinline__ void operator()(const f32x4 (&acc)[2][2][4][2], const Unit& u, int wr, int wc, int fr, int fq) const {
        const int row0 = u.pm * BM + wr * 64 + fr; int colt = u.pn * BM; bf16_t* base = O;
        float sc = 1.f; if (split_cols) { const int t = colt / split_cols; base += (size_t)t * split_stride; colt -= t * split_cols; if (t == 0) sc = scale0; }
        const int col0 = colt + wc * 32 + 8 * fq, bcol0 = u.pn * BM + wc * 32 + 8 * fq;
        f32x4 bv[2][2];
#pragma unroll
        for (int bj = 0; bj < 2; ++bj)
#pragma unroll
            for (int n = 0; n < 2; ++n) bv[bj][n] = bias ? *(const f32x4*)(bias + bcol0 + bj * HALF + 4 * n) : (f32x4){0.f, 0.f, 0.f, 0.f};
#pragma unroll
        for (int ai = 0; ai < 2; ++ai)
#pragma unroll
            for (int m = 0; m < 4; ++m) { bf16_t* rowp = base + (size_t)(row0 + ai * HALF + m * 16) * ldc + col0;
#pragma unroll
                for (int bj = 0; bj < 2; ++bj) { f32x4 v0 = acc[ai][bj][m][0] + bv[bj][0], v1 = acc[ai][bj][m][1] + bv[bj][1];
                    if (ACT == 1) { f32x2 a = gelu_pk((f32x2){v0[0], v0[1]}), b = gelu_pk((f32x2){v0[2], v0[3]}), c = gelu_pk((f32x2){v1[0], v1[1]}), d = gelu_pk((f32x2){v1[2], v1[3]});
                        v0 = (f32x4){a.x, a.y, b.x, b.y}; v1 = (f32x4){c.x, c.y, d.x, d.y}; }
                    v0 = v0 * sc; v1 = v1 * sc; u32x4 w; w.x = cvt_pk_bf16(v0[0], v0[1]); w.y = cvt_pk_bf16(v0[2], v0[3]); w.z = cvt_pk_bf16(v1[0], v1[1]); w.w = cvt_pk_bf16(v1[2], v1[3]);
                    *(u32x4*)(rowp + bj * HALF) = w; } }
    }
};

template <int ACT  > struct EpiOut {
    static constexpr bool PERM = true, AFTER_DRAIN = false;
    bf16_t* O; int ldc;
    __device__ __forceinline__ void operator()(const f32x4 (&acc)[2][2][4][2], const Unit& u, int wr, int wc, int fr, int fq) const {
        const int row0 = u.pm * BM + wr * 64 + fr; const int col0 = u.pn * BM + wc * 32 + 8 * fq;
#pragma unroll
        for (int ai = 0; ai < 2; ++ai)
#pragma unroll
            for (int m = 0; m < 4; ++m) { bf16_t* rowp = O + (size_t)(row0 + ai * HALF + m * 16) * ldc + col0;
#pragma unroll
                for (int bj = 0; bj < 2; ++bj) { f32x4 v0 = acc[ai][bj][m][0], v1 = acc[ai][bj][m][1];
                    if (ACT == 2) {
#pragma unroll
                        for (int e = 0; e < 4; ++e) { float a = fmaxf(v0[e], 0.f), b = fmaxf(v1[e], 0.f); v0[e] = a * a; v1[e] = b * b; } }
                    u32x4 w; w.x = cvt_pk_bf16(v0[0], v0[1]); w.y = cvt_pk_bf16(v0[2], v0[3]); w.z = cvt_pk_bf16(v1[0], v1[1]); w.w = cvt_pk_bf16(v1[2], v1[3]);
                    *(u32x4*)(rowp + bj * HALF) = w; } }
    }
};
struct EpiProj {
    static constexpr bool PERM = true, AFTER_DRAIN = false;
    bf16_t* O; int ldc; float* G; int npn;
    __device__ __forceinline__ void operator()(const f32x4 (&acc)[2][2][4][2], const Unit& u, int wr, int wc, int fr, int fq) const {
        const int row0 = u.pm * BM + wr * 64 + fr;
        if (u.pn < npn) {
            const int col0 = u.pn * BM + wc * 32 + 8 * fq;
#pragma unroll
            for (int ai = 0; ai < 2; ++ai)
#pragma unroll
                for (int m = 0; m < 4; ++m) { bf16_t* rowp = O + (size_t)(row0 + ai * HALF + m * 16) * ldc + col0;
#pragma unroll
                    for (int bj = 0; bj < 2; ++bj) { const f32x4 v0 = acc[ai][bj][m][0], v1 = acc[ai][bj][m][1];
                        u32x4 w; w.x = cvt_pk_bf16(v0[0], v0[1]); w.y = cvt_pk_bf16(v0[2], v0[3]); w.z = cvt_pk_bf16(v1[0], v1[1]); w.w = cvt_pk_bf16(v1[2], v1[3]);
                        *(u32x4*)(rowp + bj * HALF) = w; } }
        } else if (wc == 0 && fq < 2) {
#pragma unroll
            for (int ai = 0; ai < 2; ++ai)
#pragma unroll
                for (int m = 0; m < 4; ++m) { float* gp = G + (size_t)(row0 + ai * HALF + m * 16) * 16 + 8 * fq;
                    *(f32x4*)gp = acc[ai][0][m][0]; *(f32x4*)(gp + 4) = acc[ai][0][m][1]; }
        }
    }
};
template <class Epi, class Sched, bool ALIGN_EPI = false, bool SP2 = false>
__device__ __forceinline__ void gemm_phase(PG8_LAS unsigned char* lds, const Gemm g, const Sched& S, const Epi& E) {
    int tid_o = threadIdx.x; asm volatile("" : "+v"(tid_o));
    const int tid = tid_o, wid = __builtin_amdgcn_readfirstlane(tid >> 6), lane = tid & 63, wr = wid >> 2, wc = wid & 3, fr = lane & 15, fq = lane >> 4;
    const int K = g.K, nt = K / BK;
    unsigned voffA[2], voffB[2];
#pragma unroll
    for (int i = 0; i < 2; ++i) { int R, C; stage_rc(tid * 16 + i * 8192, R, C); const int Rb = Epi::PERM ? ((R & ~31) + perm32(R & 31)) : R;
        voffA[i] = (unsigned)(R * K + C) * 2u; voffB[i] = (unsigned)(Rb * K + C) * 2u; }
    const size_t kstep = (size_t)(BK * 2);
    const size_t hstep = (size_t)HALF * K * 2;
    const size_t tstep = 2 * hstep;
    const unsigned ldsw = (unsigned)wid * 1024u;
    const int aoff = lds_byte(wr * 64 + fr, fq * 8), boff = lds_byte(wc * 32 + fr, fq * 8);
#define PG8_SA(b, h) (((b) * 2 + (h)) * HTB)
#define PG8_SB(b, h) ((4 + (b) * 2 + (h)) * HTB)
#define PG8_STAGE(bufoff, gbase, voff) do { _Pragma("unroll") for (int _i = 0; _i < 2; ++_i) \
        __builtin_amdgcn_global_load_lds((const unsigned*)((const char*)(gbase) + (voff)[_i]), (PG8_LAS unsigned*)(lds + (bufoff) + ldsw + _i * 8192), 16, 0, 0); } while (0)
#define PG8_LDA(dst, b, h) do { _Pragma("unroll") for (int m = 0; m < 4; ++m) _Pragma("unroll") for (int k = 0; k < 2; ++k) dst[m][k] = *(const PG8_LAS bf16x8*)(lds + PG8_SA(b, h) + aoff + m * 2048 + k * 1024); } while (0)
#define PG8_LDB(dst, b, h) do { _Pragma("unroll") for (int n = 0; n < 2; ++n) _Pragma("unroll") for (int k = 0; k < 2; ++k) dst[n][k] = *(const PG8_LAS bf16x8*)(lds + PG8_SB(b, h) + boff + n * 2048 + k * 1024); } while (0)
#define PG8_MMA(ai, bj, At, Bt) do { __builtin_amdgcn_s_setprio(1); _Pragma("unroll") for (int m = 0; m < 4; ++m) _Pragma("unroll") for (int n = 0; n < 2; ++n) _Pragma("unroll") for (int k = 0; k < 2; ++k) \
        acc[ai][bj][m][n] = __builtin_amdgcn_mfma_f32_16x16x32_bf16(Bt[n][k], At[m][k], acc[ai][bj][m][n], 0, 0, 0); __builtin_amdgcn_s_setprio(0); } while (0)
#define PG8_WAIT_V(n) asm volatile("s_waitcnt vmcnt(" #n ")" ::: "memory")
#define PG8_WAIT_L(n) asm volatile("s_waitcnt lgkmcnt(" #n ")" ::: "memory")
#define PG8_BAR __builtin_amdgcn_s_barrier()
#define PG8_SCHED __builtin_amdgcn_sched_barrier(0)
    Unit cur, nxt; int ui = 0;
    if (!S.next(0, cur)) return;
    f32x4 acc[2][2][4][2];
#pragma unroll
    for (int a = 0; a < 2; ++a)
#pragma unroll
        for (int b = 0; b < 2; ++b)
#pragma unroll
            for (int m = 0; m < 4; ++m)
#pragma unroll
                for (int n = 0; n < 2; ++n) acc[a][b][m][n] = (f32x4){0.f, 0.f, 0.f, 0.f};
    bf16x8 At[4][2], B0[2][2], B1[2][2];
    const char* cA = (const char*)g.A + (size_t)cur.pm * tstep; const char* cB = (const char*)g.Bt + (size_t)cur.pn * tstep;
    S.a_ready(cur);
    if constexpr (SP2) {
        PG8_STAGE(PG8_SB(0, 0), cB, voffB); PG8_STAGE(PG8_SB(0, 1), cB + hstep, voffB); PG8_STAGE(PG8_SA(0, 0), cA, voffA); PG8_STAGE(PG8_SA(0, 1), cA + hstep, voffA);
        if (wr == 1) PG8_BAR;
        PG8_WAIT_V(2); PG8_BAR;
        PG8_STAGE(PG8_SB(1, 0), cB + kstep, voffB); PG8_STAGE(PG8_SA(1, 0), cA + kstep, voffA); PG8_STAGE(PG8_SB(1, 1), cB + hstep + kstep, voffB);
        PG8_WAIT_V(6); PG8_BAR;
    } else {
        PG8_STAGE(PG8_SB(0, 0), cB, voffB); PG8_STAGE(PG8_SA(0, 0), cA, voffA); PG8_STAGE(PG8_SB(0, 1), cB + hstep, voffB); PG8_STAGE(PG8_SA(0, 1), cA + hstep, voffA);
        if (wr == 1) PG8_BAR;
        PG8_WAIT_V(4); PG8_BAR;
        PG8_STAGE(PG8_SB(1, 0), cB + kstep, voffB); PG8_STAGE(PG8_SA(1, 0), cA + kstep, voffA); PG8_STAGE(PG8_SB(1, 1), cB + hstep + kstep, voffB);
        PG8_WAIT_V(6); PG8_BAR;
    }
    for (;;) {
        const bool has_next = S.next(ui + 1, nxt);
        const char* nA = has_next ? (const char*)g.A + (size_t)nxt.pm * tstep : cA; const char* nB = has_next ? (const char*)g.Bt + (size_t)nxt.pn * tstep : cB;
        for (int t = 0; t < nt; t += 2) {
            const bool last = (t == nt - 2);
            const char* a1 = cA + (size_t)(t + 1) * kstep;
            const char* a2 = last ? nA : cA + (size_t)(t + 2) * kstep; const char* b2 = last ? nB : cB + (size_t)(t + 2) * kstep;
            const char* a3 = a2 + kstep; const char* b3 = b2 + kstep;
            if (last && has_next) S.a_ready(nxt);
            if constexpr (SP2) {
            PG8_LDB(B0, 0, 0); PG8_LDB(B1, 0, 1); PG8_SCHED; PG8_LDA(At, 0, 0); PG8_STAGE(PG8_SA(1, 1), a1 + hstep, voffA);
            PG8_WAIT_V(8); PG8_WAIT_L(0); PG8_BAR; PG8_MMA(0, 0, At, B0); PG8_MMA(0, 1, At, B1); PG8_BAR; PG8_SCHED;
            PG8_LDA(At, 0, 1); PG8_STAGE(PG8_SB(0, 0), b2, voffB); PG8_STAGE(PG8_SB(0, 1), b2 + hstep, voffB); PG8_STAGE(PG8_SA(0, 0), a2, voffA);
            PG8_WAIT_V(8); PG8_WAIT_L(0); PG8_BAR; PG8_MMA(1, 0, At, B0); PG8_MMA(1, 1, At, B1); PG8_BAR; PG8_SCHED;
            PG8_LDB(B0, 1, 0); PG8_LDB(B1, 1, 1); PG8_SCHED; PG8_LDA(At, 1, 0); PG8_STAGE(PG8_SA(0, 1), a2 + hstep, voffA);
            PG8_WAIT_V(8); PG8_WAIT_L(0); PG8_BAR; PG8_MMA(0, 0, At, B0); PG8_MMA(0, 1, At, B1); PG8_BAR; PG8_SCHED;
            PG8_LDA(At, 1, 1); PG8_STAGE(PG8_SB(1, 0), b3, voffB); PG8_STAGE(PG8_SB(1, 1), b3 + hstep, voffB); PG8_STAGE(PG8_SA(1, 0), a3, voffA);
            PG8_WAIT_V(8); PG8_WAIT_L(0); PG8_BAR; PG8_MMA(1, 0, At, B0); PG8_MMA(1, 1, At, B1); PG8_BAR; PG8_SCHED;
            } else {
            PG8_LDB(B0, 0, 0); PG8_SCHED; PG8_LDA(At, 0, 0); PG8_STAGE(PG8_SA(1, 1), a1 + hstep, voffA);
            PG8_WAIT_L(8); PG8_BAR; PG8_WAIT_L(0); PG8_MMA(0, 0, At, B0); PG8_BAR; PG8_SCHED;
            PG8_LDB(B1, 0, 1); PG8_STAGE(PG8_SB(0, 0), b2, voffB);
            PG8_BAR; PG8_WAIT_L(0); PG8_MMA(0, 1, At, B1); PG8_BAR;
            PG8_LDA(At, 0, 1); PG8_STAGE(PG8_SA(0, 0), a2, voffA);
            PG8_BAR; PG8_WAIT_L(0); PG8_MMA(1, 0, At, B0); PG8_BAR; PG8_SCHED;
            PG8_STAGE(PG8_SB(0, 1), b2 + hstep, voffB);
            PG8_WAIT_V(6); PG8_BAR; PG8_MMA(1, 1, At, B1); PG8_BAR;
            PG8_LDB(B0, 1, 0); PG8_SCHED; PG8_LDA(At, 1, 0); PG8_STAGE(PG8_SA(0, 1), a2 + hstep, voffA);
            PG8_WAIT_L(8); PG8_BAR; PG8_WAIT_L(0); PG8_MMA(0, 0, At, B0); PG8_BAR; PG8_SCHED;
            PG8_LDB(B1, 1, 1); PG8_STAGE(PG8_SB(1, 0), b3, voffB);
            PG8_BAR; PG8_WAIT_L(0); PG8_MMA(0, 1, At, B1); PG8_BAR;
            PG8_LDA(At, 1, 1); PG8_STAGE(PG8_SA(1, 0), a3, voffA);
            PG8_BAR; PG8_WAIT_L(0); PG8_MMA(1, 0, At, B0); PG8_BAR; PG8_SCHED;
            PG8_STAGE(PG8_SB(1, 1), b3 + hstep, voffB);
            PG8_WAIT_V(6); PG8_BAR; PG8_MMA(1, 1, At, B1); PG8_BAR;
            }
        }
        if constexpr (ALIGN_EPI) { if (wr == 0) PG8_BAR; }
        if constexpr (!Epi::AFTER_DRAIN) { E(acc, cur, wr, wc, fr, fq); S.done(cur); }
        if (!has_next) break;
#pragma unroll
        for (int a = 0; a < 2; ++a)
#pragma unroll
            for (int b = 0; b < 2; ++b)
#pragma unroll
                for (int m = 0; m < 4; ++m)
#pragma unroll
                    for (int n = 0; n < 2; ++n) acc[a][b][m][n] = (f32x4){0.f, 0.f, 0.f, 0.f};
        cur = nxt; cA = nA; cB = nB; ++ui;
        if constexpr (ALIGN_EPI) { if (wr == 1) PG8_BAR; }
    }
    PG8_WAIT_V(0);
    if constexpr (!ALIGN_EPI) { if (wr == 0) PG8_BAR; }
    PG8_BAR;
    if constexpr (Epi::AFTER_DRAIN) { E.fused(acc, cur, wr, wc, fr, fq, lds, wid, lane); S.done(cur); }
#undef PG8_SA
#undef PG8_SB
#undef PG8_STAGE
#undef PG8_LDA
#undef PG8_LDB
#undef PG8_MMA
#undef PG8_WAIT_V
#undef PG8_WAIT_L
#undef PG8_BAR
#undef PG8_SCHED
}
}
#ifndef PG8_SP2
#define PG8_SP2 true
#endif
#ifndef PG8_ALIGN
#define PG8_ALIGN true
#endif
#ifndef MK_MULTI
#define MK_MULTI 0
#endif

constexpr int NB = 4, S = 8192, D = 1024, T = NB * S, FF = 4096;
constexpr int NWAVES = 8, NTHR = 512;
constexpr float EPS = 1e-6f;
constexpr int NPHASE = 20;

constexpr size_t MiB = 1u << 20;
constexpr size_t WS_ADA = 1 * MiB;
constexpr size_t WS_COS = 2 * MiB, WS_SIN = 6 * MiB;
constexpr size_t WS_G = 10 * MiB;
constexpr size_t WS_AARR = 12 * MiB, WS_BARR = 13 * MiB, WS_CMARR = 14 * MiB;
constexpr size_t WS_AMAX = 15 * MiB, WS_BL = 15 * MiB + 8192, WS_MPREV = 15 * MiB + 16384;
constexpr size_t WS_W = 16 * MiB;
constexpr size_t W_IN = WS_W, W_V = W_IN + (size_t)2304 * 1024 * 2, W_AO = W_V + (size_t)1024 * 1024 * 2;
constexpr size_t W_1A = W_AO + 2 * MiB, W_2A = W_1A + 8 * MiB, W_1B = W_2A + 8 * MiB, W_2B = W_1B + 8 * MiB;
constexpr size_t W_KVA = W_2B + 8 * MiB, W_BK = W_KVA + 1 * MiB, W_BV = W_BK + MiB / 2, W_QA = W_BV + MiB / 2, W_QB = W_QA + 1 * MiB, W_BO = W_QB + (size_t)1536 * 384 * 2, W_END = W_BO + 2 * MiB;
static_assert(W_END <= 64 * MiB, "weights region");
constexpr size_t WS_Y = 64 * MiB;
constexpr size_t WS_CIN = 64 * MiB, WS_DN = 96 * MiB, WS_NIN = 97 * MiB;
constexpr size_t WS_H = 128 * MiB;
constexpr size_t WS_H2 = 192 * MiB;
constexpr size_t WS_CST = 192 * MiB;
constexpr size_t WS_Q = 128 * MiB;
constexpr size_t WS_R = 256 * MiB;
constexpr size_t WS_P = WS_R, WS_VTA = WS_R + 128 * MiB;
constexpr size_t WS_U = WS_R;
constexpr size_t WS_KVA = WS_R, WS_QA = WS_R + 32 * MiB, WS_CKV = WS_R + 64 * MiB, WS_KR = WS_R + 80 * MiB, WS_CQ = WS_R + 84 * MiB, WS_KN = WS_R + 108 * MiB, WS_VTB = WS_R + 172 * MiB;
constexpr size_t WS_O = WS_R;
constexpr size_t WS_END = 512 * MiB;
static_assert(WS_VTB + 64 * MiB <= WS_END, "ws map");

constexpr int LDS_BYTES = 147456;

#define LAS __attribute__((address_space(3)))
typedef unsigned short bf16;
typedef unsigned v4u __attribute__((ext_vector_type(4)));
typedef unsigned v2u __attribute__((ext_vector_type(2)));
typedef float f32x4 __attribute__((ext_vector_type(4)));
typedef float f32x2 __attribute__((ext_vector_type(2)));
typedef float f32x16 __attribute__((ext_vector_type(16)));
typedef short bf16x8 __attribute__((ext_vector_type(8)));
typedef short s16x4 __attribute__((ext_vector_type(4)));
typedef __bf16 bf2_t __attribute__((ext_vector_type(2)));
#define DI __device__ __forceinline__
#define MFMA32(a, b, c) __builtin_amdgcn_mfma_f32_32x32x16_bf16((a), (b), (c), 0, 0, 0)

DI unsigned pk2(float lo, float hi) { f32x2 v = {lo, hi}; bf2_t r = __builtin_convertvector(v, bf2_t); return __builtin_bit_cast(unsigned, r); }
DI float bflo(unsigned u) { return __uint_as_float(u << 16); }
DI float bfhi(unsigned u) { return __uint_as_float(u & 0xffff0000u); }
DI float bf2f(short s) { return __uint_as_float(((unsigned)(unsigned short)s) << 16); }
DI int crow(int i, int h) { return (i & 3) + 8 * (i >> 2) + 4 * h; }
DI float wave_sum(float v) {
#pragma unroll
    for (int o = 1; o < 64; o <<= 1) v += __shfl_xor(v, o);
    return v;
}
DI bf16x8 pack8(float a0, float a1, float a2, float a3, float a4, float a5, float a6, float a7) {
    v4u p; p.x = pk2(a0, a1); p.y = pk2(a2, a3); p.z = pk2(a4, a5); p.w = pk2(a6, a7); return __builtin_bit_cast(bf16x8, p);
}


typedef __attribute__((address_space(1))) unsigned gu32;
#define RLX_AGENT __ATOMIC_RELAXED, __HIP_MEMORY_SCOPE_AGENT
constexpr int CW_BAR = 4096;
constexpr size_t CTL_ZERO_BYTES = 65536;
constexpr int MISC_OFF = 135168;
#define XB_TMO      128
#define XB_XCNT(j)  (256  + 64 * (j))
#define XB_XSUB(j)  (1280 + 64 * (j))
#define XB_XGEN(j)  (2304 + 64 * (j))
#define XB_TOP      3328
#define XB_TOPGEN   3392
#define XCD_BAR_WORDS 3456
#define XB_SPIN_CAP (1u << 18)

__device__ __forceinline__ unsigned xb_ld(unsigned* p)              { return __hip_atomic_load(p, __ATOMIC_RELAXED, __HIP_MEMORY_SCOPE_AGENT); }
__device__ __forceinline__ unsigned xb_add(unsigned* p, unsigned v) { return __hip_atomic_fetch_add(p, v, __ATOMIC_RELAXED, __HIP_MEMORY_SCOPE_AGENT); }
__device__ __forceinline__ unsigned xb_xcc_id() { return (unsigned)__builtin_amdgcn_s_getreg((3 << 11) | 20) & 0xFu; }
#define XB_SPIN(cond, bar) do { unsigned _sp = 0; while (cond) { __builtin_amdgcn_s_sleep(1); \
    if ((++_sp & 255u) == 0u) { if (xb_ld(&(bar)[XB_TMO])) break; if (_sp > XB_SPIN_CAP) { atomicAdd(&(bar)[XB_TMO], 1u); break; } } } } while (0)

struct XcdBarrier {
    unsigned* bar; unsigned x;
    volatile LAS unsigned* st;
};

__device__ __forceinline__ XcdBarrier xcd_barrier_post(unsigned* bar, volatile LAS unsigned* st) {
    XcdBarrier b; b.bar = bar; b.x = xb_xcc_id(); b.st = st;
    if (threadIdx.x == 0) (void)xb_add(&bar[XB_XCNT(b.x)], 1u);
    return b;
}
__device__ __forceinline__ void xcd_barrier_complete(unsigned* bar, unsigned x, unsigned& nloc, unsigned& nx) {
    const unsigned G = gridDim.x * gridDim.y * gridDim.z;
    unsigned sum, cnt, mine, sp = 0u;
    for (;;) {
        sum = 0u; cnt = 0u; mine = 0u;
#pragma unroll
        for (unsigned j = 0; j < 16; ++j) { const unsigned c = xb_ld(&bar[XB_XCNT(j)]); sum += c; cnt += (c > 0u) ? 1u : 0u; mine = (j == x) ? c : mine; }
        if (sum == G) break;
        __builtin_amdgcn_s_sleep(1);
        if ((++sp & 255u) == 0u) { if (xb_ld(&bar[XB_TMO])) break; if (sp > XB_SPIN_CAP) { atomicAdd(&bar[XB_TMO], 1u); break; } }
    }
    nloc = mine > 0u ? mine : 1u; nx = cnt > 0u ? cnt : 1u;
}

__device__ __forceinline__ void xcd_barrier(const XcdBarrier& b) {
    asm volatile("s_waitcnt vmcnt(0)" ::: "memory");
    __syncthreads();
    if (threadIdx.x == 0) {
        unsigned* bar = b.bar;
        __builtin_amdgcn_s_waitcnt(0);
        unsigned nloc = b.st[0], nx = b.st[1];
        if (nloc == 0u) { xcd_barrier_complete(bar, b.x, nloc, nx); b.st[0] = nloc; b.st[1] = nx; }
        const unsigned old = xb_add(&bar[XB_XSUB(b.x)], 1u);
        const unsigned gen = old / nloc;
        if (old + 1u == (gen + 1u) * nloc) {
            __builtin_amdgcn_fence(__ATOMIC_RELEASE, "agent");
            asm volatile("s_waitcnt vmcnt(0)" ::: "memory");
            const unsigned og = xb_add(&bar[XB_TOP], 1u);
            const unsigned tg = og / nx;
            if (og + 1u == (tg + 1u) * nx) xb_add(&bar[XB_TOPGEN], 1u);
            else XB_SPIN(xb_ld(&bar[XB_TOPGEN]) == tg, bar);
            __builtin_amdgcn_fence(__ATOMIC_ACQUIRE, "agent");
            xb_add(&bar[XB_XGEN(b.x)], 1u);
            asm volatile("s_waitcnt vmcnt(0)" ::: "memory");
        } else {
            XB_SPIN(xb_ld(&bar[XB_XGEN(b.x)]) == gen, bar);
            __builtin_amdgcn_fence(__ATOMIC_ACQUIRE, "agent");
            asm volatile("s_waitcnt vmcnt(0)" ::: "memory");
        }
    }
    __syncthreads();
}


struct Args {
    const float* in[22]; float* out; unsigned char* ws; float inv_freq[32]; int ph_lo, ph_hi;
};

struct Frame {
    LAS unsigned char* lds; int tid, lane, wave, G, bid;
};

struct TrItem { const float* W; bf16* WT; int ldw, col0, nvalid, K, row0, kb, nb; };
DI void tr_load(const TrItem& t, int lane, f32x4 (&v)[16]) {
    const int k0 = 64 * t.kb, n0 = 64 * t.nb; const int c4 = lane & 7, kr = lane >> 3;
#pragma unroll
    for (int hf = 0; hf < 2; ++hf) { const bool ok = (n0 + 32 * hf + 4 * c4) < t.nvalid;
#pragma unroll
        for (int i = 0; i < 8; ++i) v[8 * hf + i] = ok ? *(const f32x4*)(t.W + (size_t)(k0 + 8 * i + kr) * t.ldw + t.col0 + n0 + 32 * hf + 4 * c4) : (f32x4){0.f, 0.f, 0.f, 0.f}; }
}
DI void tr_finish(const TrItem& t, int lane, const f32x4 (&v)[16], LAS float* scr) {
    const int k0 = 64 * t.kb; const int c4 = lane & 7, kr = lane >> 3;
#pragma unroll
    for (int hf = 0; hf < 2; ++hf) { const int n0 = 64 * t.nb + 32 * hf;
#pragma unroll
        for (int i = 0; i < 8; ++i) { LAS float* d = scr + (8 * i + kr) * 33 + 4 * c4; d[0] = v[8 * hf + i].x; d[1] = v[8 * hf + i].y; d[2] = v[8 * hf + i].z; d[3] = v[8 * hf + i].w; }
        asm volatile("s_waitcnt lgkmcnt(0)" ::: "memory");
        const int ch = lane & 7;
#pragma unroll
        for (int j = 0; j < 4; ++j) { const int n = (lane >> 3) + 8 * j; const LAS float* s = scr + (8 * ch) * 33 + n;
            v4u o; o.x = pk2(s[0 * 33], s[1 * 33]); o.y = pk2(s[2 * 33], s[3 * 33]); o.z = pk2(s[4 * 33], s[5 * 33]); o.w = pk2(s[6 * 33], s[7 * 33]);
            *(v4u*)(t.WT + (size_t)(t.row0 + n0 + n) * t.K + k0 + 8 * ch) = o; }
        asm volatile("s_waitcnt lgkmcnt(0)" ::: "memory"); }
}
constexpr int TR_TOTAL = (512 * 4 + 128 + 2048 * 4 + 256 + 16 * 16 + 256 + 288 + 512) / 2;
DI void tr_decode(const Args& a, int g, TrItem& t) {
    unsigned char* ws = a.ws; const float* w_in = a.in[6];
#define TR_JOB(n_, W_, ldw_, col0_, nvalid_, K_, WT_, row0_, nrows_) if (g < (n_) / 2) { t.W = (W_); t.ldw = (ldw_); t.col0 = (col0_); t.nvalid = (nvalid_); t.K = (K_); t.WT = (bf16*)(WT_); t.row0 = (row0_); \
        const int nblk_ = (nrows_) / 64; t.kb = g / nblk_; t.nb = g % nblk_; return; } g -= (n_) / 2;
    TR_JOB(512, w_in, 3088, 0, 1024, 1024, ws + W_IN, 0, 1024)
    TR_JOB(512, w_in, 3088, 2064, 1024, 1024, ws + W_IN, 1024, 1024)
    TR_JOB(128, w_in, 3088, 2048, 16, 1024, ws + W_IN, 2048, 256)
    TR_JOB(512, w_in, 3088, 1024, 1024, 1024, ws + W_V, 0, 1024)
    TR_JOB(512, a.in[9], 1024, 0, 1024, 1024, ws + W_AO, 0, 1024)
    TR_JOB(2048, a.in[20], 4096, 0, 4096, 1024, ws + W_1A, 0, 4096)
    TR_JOB(2048, a.in[21], 1024, 0, 1024, 4096, ws + W_2A, 0, 1024)
    TR_JOB(2048, a.in[20] + (size_t)1024 * 4096, 4096, 0, 4096, 1024, ws + W_1B, 0, 4096)
    TR_JOB(2048, a.in[21] + (size_t)4096 * 1024, 1024, 0, 1024, 4096, ws + W_2B, 0, 1024)
    TR_JOB(256, a.in[13], 320, 0, 320, 1024, ws + W_KVA, 0, 512)
    { const int j = g >> 3;
      if (j < 16) { const int h = j >> 1, isv = j & 1; g &= 7; t.W = a.in[15]; t.ldw = 2048; t.col0 = h * 256 + 128 * isv; t.nvalid = 128; t.K = 256; t.WT = (bf16*)(ws + (isv ? W_BV : W_BK)); t.row0 = h * 128;
                    t.kb = g / 2; t.nb = g % 2; return; }
      g -= 128; }
    TR_JOB(256, a.in[16], 384, 0, 384, 1024, ws + W_QA, 0, 512)
    TR_JOB(288, a.in[18], 1536, 0, 1536, 384, ws + W_QB, 0, 1536)
    TR_JOB(512, a.in[19], 1024, 0, 1024, 1024, ws + W_BO, 0, 1024)
#undef TR_JOB
}
DI void p0_weights(Frame& F, const Args& a) {
    LAS float* scr = (LAS float*)(F.lds + F.wave * 16384);
    const int gw = F.bid * NWAVES + F.wave, NGW = F.G * NWAVES;
    int g = gw; if (g >= TR_TOTAL) return;
    TrItem cur; f32x4 v[16];
    tr_decode(a, g, cur); tr_load(cur, F.lane, v);
    for (;;) {
        const int gn = g + NGW; const bool hn = gn < TR_TOTAL;
        TrItem nx; f32x4 vn[16];
        if (hn) { tr_decode(a, gn, nx); tr_load(nx, F.lane, vn); }
        tr_finish(cur, F.lane, v, scr);
        if (!hn) break;
        cur = nx; g = gn;
#pragma unroll
        for (int i = 0; i < 16; ++i) v[i] = vn[i];
    }
}

DI void p0_ada(Frame& F, const Args& a) {
    LAS float* cond = (LAS float*)F.lds;
    LAS float* part = (LAS float*)(F.lds + 16384);
    const float* c = a.in[1];
    __syncthreads();
    for (int i = F.tid; i < 4096; i += NTHR) { const float v = c[i]; cond[i] = v / (1.f + __expf(-v)); }
    __syncthreads();
    float* ADA = (float*)(a.ws + WS_ADA);
    constexpr int NI = 96 + 96 + 32;
    for (int it = F.bid; it < NI; it += F.G) {
        const float* W; const float* bias; int N, n0; float* out;
        if (it < 96) { W = a.in[3]; bias = a.in[4]; N = 6144; n0 = it * 64; out = ADA; }
        else if (it < 192) { W = a.in[3] + (size_t)1024 * 6144; bias = a.in[4] + 6144; N = 6144; n0 = (it - 96) * 64; out = ADA + 4 * 6144; }
        else { W = a.in[10]; bias = a.in[11]; N = 2048; n0 = (it - 192) * 64; out = ADA + 8 * 6144; }
        float s0 = 0.f, s1 = 0.f, s2 = 0.f, s3 = 0.f;
        const float* wp = W + (size_t)(F.wave * 128) * N + n0 + F.lane;
#pragma unroll 32
        for (int k = 0; k < 128; ++k) { const float w = wp[(size_t)k * N]; const int kk = F.wave * 128 + k;
            s0 += cond[kk] * w; s1 += cond[1024 + kk] * w; s2 += cond[2048 + kk] * w; s3 += cond[3072 + kk] * w; }
        part[(F.wave * 4 + 0) * 64 + F.lane] = s0; part[(F.wave * 4 + 1) * 64 + F.lane] = s1; part[(F.wave * 4 + 2) * 64 + F.lane] = s2; part[(F.wave * 4 + 3) * 64 + F.lane] = s3;
        __syncthreads();
        if (F.tid < 256) { const int b = F.tid >> 6, l = F.tid & 63; float s = 0.f;
#pragma unroll
            for (int w = 0; w < 8; ++w) s += part[(w * 4 + b) * 64 + l];
            out[(size_t)b * N + n0 + l] = s + bias[n0 + l]; }
        __syncthreads();
    }
}
DI void p0_rope(Frame& F, const Args& a) {
    const int* pos = (const int*)a.in[2];
    float* COS = (float*)(a.ws + WS_COS); float* SIN = (float*)(a.ws + WS_SIN);
    const int i = F.tid & 31; const float inv = a.inv_freq[i];
    const int tpw = T / (F.G * 16), t0 = (F.bid * 16 + (F.tid >> 5)) * tpw;
    for (int tb = 0; tb < tpw; tb += 8) {
        int p[8];
#pragma unroll
        for (int j = 0; j < 8; ++j) p[j] = pos[t0 + tb + j];
#pragma unroll
        for (int j = 0; j < 8; ++j) { const int t = t0 + tb + j;
            const float ang = (float)p[j] * inv;
            const double rev = (double)ang * 0.15915494309189533577;
            const float fr = (float)__builtin_amdgcn_fract(rev);
            COS[(size_t)t * 32 + i] = __builtin_amdgcn_cosf(fr); SIN[(size_t)t * 32 + i] = __builtin_amdgcn_sinf(fr); }
    }
}

template <bool HAS_Y, int NOUT, bool XIN16, bool XOUT16>
DI void row_phase(Frame& F, const void* xin_, void* xout_, const bf16* y, const float* gy, const float* gate, int gstride,
                  const float* g0, const float* sh0, const float* sc0, int st0, bf16* out0,
                  const float* g1, const float* sh1, const float* sc1, int st1, bf16* out1) {
    const int gw = F.bid * NWAVES + F.wave, NGW = F.G * NWAVES, lane = F.lane;
    const int rpw = T / NGW, m0 = gw * rpw, b = m0 / S;
    f32x4 Gv[4], A0[4], B0[4], A1[4], B1[4];
#pragma unroll
    for (int j = 0; j < 4; ++j) { const int c = 4 * lane + 256 * j;
        if (HAS_Y) Gv[j] = *(const f32x4*)(gate + (size_t)b * gstride + c) * *(const f32x4*)(gy + c);
        if (NOUT > 0) { A0[j] = *(const f32x4*)(g0 + c) * (*(const f32x4*)(sc0 + (size_t)b * st0 + c) + 1.f); B0[j] = *(const f32x4*)(sh0 + (size_t)b * st0 + c); }
        if (NOUT > 1) { A1[j] = *(const f32x4*)(g1 + c) * (*(const f32x4*)(sc1 + (size_t)b * st1 + c) + 1.f); B1[j] = *(const f32x4*)(sh1 + (size_t)b * st1 + c); } }
    for (int rr = 0; rr < rpw; rr += 2) {
        f32x4 v[2][4], yv[2][4];
#pragma unroll
        for (int q = 0; q < 2; ++q) { const int m = m0 + rr + q;
#pragma unroll
            for (int j = 0; j < 4; ++j) {
                if (XIN16) { const v2u u = *(const v2u*)((const bf16*)xin_ + (size_t)m * D + 4 * lane + 256 * j); v[q][j] = (f32x4){bflo(u.x), bfhi(u.x), bflo(u.y), bfhi(u.y)}; }
                else v[q][j] = *(const f32x4*)((const float*)xin_ + (size_t)m * D + 4 * lane + 256 * j);
                if (HAS_Y) { const v2u u = *(const v2u*)(y + (size_t)m * D + 4 * lane + 256 * j); yv[q][j] = (f32x4){bflo(u.x), bfhi(u.x), bflo(u.y), bfhi(u.y)}; }
            } }
#pragma unroll
        for (int q = 0; q < 2; ++q) { const int m = m0 + rr + q;
            if (HAS_Y) {
                float ss = 0.f;
#pragma unroll
                for (int j = 0; j < 4; ++j) ss += (yv[q][j].x * yv[q][j].x + yv[q][j].y * yv[q][j].y) + (yv[q][j].z * yv[q][j].z + yv[q][j].w * yv[q][j].w);
                const float rinv = rsqrtf(wave_sum(ss) * (1.f / D) + EPS);
#pragma unroll
                for (int j = 0; j < 4; ++j) { const int c = 4 * lane + 256 * j;
                    v[q][j] = v[q][j] + Gv[j] * (yv[q][j] * rinv);
                    if (XOUT16) { v2u w; w.x = pk2(v[q][j].x, v[q][j].y); w.y = pk2(v[q][j].z, v[q][j].w); *(v2u*)((bf16*)xout_ + (size_t)m * D + c) = w;
                                  v[q][j] = (f32x4){bflo(w.x), bfhi(w.x), bflo(w.y), bfhi(w.y)}; }
                    else *(f32x4*)((float*)xout_ + (size_t)m * D + c) = v[q][j]; }
            }
            if (NOUT > 0) {
                float ss = 0.f;
#pragma unroll
                for (int j = 0; j < 4; ++j) ss += (v[q][j].x * v[q][j].x + v[q][j].y * v[q][j].y) + (v[q][j].z * v[q][j].z + v[q][j].w * v[q][j].w);
                const float rinv = rsqrtf(wave_sum(ss) * (1.f / D) + EPS);
#pragma unroll
                for (int j = 0; j < 4; ++j) { const int c = 4 * lane + 256 * j;
                    { const f32x4 o = v[q][j] * rinv * A0[j] + B0[j]; v2u w; w.x = pk2(o.x, o.y); w.y = pk2(o.z, o.w); *(v2u*)(out0 + (size_t)m * D + c) = w; }
                    if (NOUT > 1) { const f32x4 o = v[q][j] * rinv * A1[j] + B1[j]; v2u w; w.x = pk2(o.x, o.y); w.y = pk2(o.z, o.w); *(v2u*)(out1 + (size_t)m * D + c) = w; }
                }
            }
        }
    }
}
DI void latent_phase(Frame& F, const Args& a) {
    const bf16* KVA = (const bf16*)(a.ws + WS_KVA); const bf16* QA = (const bf16*)(a.ws + WS_QA);
    bf16* CKV = (bf16*)(a.ws + WS_CKV); bf16* KR = (bf16*)(a.ws + WS_KR); bf16* CQ = (bf16*)(a.ws + WS_CQ);
    const float* COS = (const float*)(a.ws + WS_COS); const float* SIN = (const float*)(a.ws + WS_SIN);
    const float* gl = a.in[14]; const float* gq = a.in[17];
    const int gw = F.bid * NWAVES + F.wave, NGW = F.G * NWAVES, lane = F.lane;
    const int rpw = T / NGW, m0 = gw * rpw;
    const f32x4 g = *(const f32x4*)(gl + 4 * lane);
    float gqv[6];
#pragma unroll
    for (int j = 0; j < 3; ++j) { gqv[2 * j] = gq[2 * lane + 128 * j]; gqv[2 * j + 1] = gq[2 * lane + 128 * j + 1]; }
#pragma unroll 2
    for (int rr = 0; rr < rpw; ++rr) { const int m = m0 + rr;
        const v2u u = *(const v2u*)(KVA + (size_t)m * 512 + 4 * lane);
        unsigned uq[3];
#pragma unroll
        for (int j = 0; j < 3; ++j) uq[j] = *(const unsigned*)(QA + (size_t)m * 512 + 2 * lane + 128 * j);
        float x1 = 0.f, x2 = 0.f, c = 0.f, s = 0.f;
        if (lane < 32) { x1 = bf2f((short)KVA[(size_t)m * 512 + 256 + lane]); x2 = bf2f((short)KVA[(size_t)m * 512 + 288 + lane]); c = COS[(size_t)m * 32 + lane]; s = SIN[(size_t)m * 32 + lane]; }
        { const f32x4 v = {bflo(u.x), bfhi(u.x), bflo(u.y), bfhi(u.y)};
          const float rinv = rsqrtf(wave_sum((v.x * v.x + v.y * v.y) + (v.z * v.z + v.w * v.w)) * (1.f / 256.f) + EPS);
          const f32x4 o = v * rinv * g; v2u w; w.x = pk2(o.x, o.y); w.y = pk2(o.z, o.w); *(v2u*)(CKV + (size_t)m * 256 + 4 * lane) = w; }
        if (lane < 32) { const unsigned o1 = pk2(x1 * c - x2 * s, 0.f), o2 = pk2(x2 * c + x1 * s, 0.f);
          KR[(size_t)m * 64 + lane] = (bf16)(o1 & 0xffffu); KR[(size_t)m * 64 + 32 + lane] = (bf16)(o2 & 0xffffu); }
        { float vv[6]; float ss = 0.f;
#pragma unroll
          for (int j = 0; j < 3; ++j) { vv[2 * j] = bflo(uq[j]); vv[2 * j + 1] = bfhi(uq[j]); ss += vv[2 * j] * vv[2 * j] + vv[2 * j + 1] * vv[2 * j + 1]; }
          const float rinv = rsqrtf(wave_sum(ss) * (1.f / 384.f) + EPS);
#pragma unroll
          for (int j = 0; j < 3; ++j) *(unsigned*)(CQ + (size_t)m * 384 + 2 * lane + 128 * j) = pk2(vv[2 * j] * rinv * gqv[2 * j], vv[2 * j + 1] * rinv * gqv[2 * j + 1]); }
    }
}

DI int ml_unit(int u) { const int h = u & 7, cc = u >> 3; return (((cc >> 6) * 8 + h) << 6) | (cc & 63); }
DI void mlstm_a(Frame& F, const Args& a) {
    LAS unsigned char* lds = F.lds;
    LAS float* a_l = (LAS float*)lds;
    LAS float* w_l = (LAS float*)(lds + 512);
    LAS unsigned char* KT = lds + 1024;
    LAS unsigned char* VT = lds + 1024 + 64 * 272;
    const bf16* P = (const bf16*)(a.ws + WS_P); const bf16* VTA = (const bf16*)(a.ws + WS_VTA); const float* G = (const float*)(a.ws + WS_G);
    float* AARR = (float*)(a.ws + WS_AARR); float* BARR = (float*)(a.ws + WS_BARR); float* CMARR = (float*)(a.ws + WS_CMARR);
    float* AMAX = (float*)(a.ws + WS_AMAX); float* BL = (float*)(a.ws + WS_BL);
    float* CST = (float*)(a.ws + WS_CST); float* DN = (float*)(a.ws + WS_DN);
    const float* gb = a.in[7];
    const int tid = F.tid, lane = F.lane, w = F.wave, r = lane & 31, hl = lane >> 5;
    v4u rk[2], rv[4]; float gi0 = 0.f, gi1 = 0.f, gf0 = 0.f, gf1 = 0.f;
#define MA_LOAD(ci_) do { const int bh_ = (ci_) >> 6, c_ = (ci_) & 63, b_ = bh_ >> 3, h_ = bh_ & 7, t0_ = b_ * S + c_ * 128; const int s_ = tid & 127; \
        _Pragma("unroll") for (int i = 0; i < 2; ++i) rk[i] = *(const v4u*)(P + (size_t)(t0_ + s_) * 2048 + 512 + h_ * 64 + 8 * ((tid >> 7) + 4 * i)); \
        _Pragma("unroll") for (int i = 0; i < 4; ++i) { const int cix = tid + 512 * i; rv[i] = *(const v4u*)(VTA + (size_t)(h_ * 128 + (cix >> 4)) * T + t0_ + 8 * (cix & 15)); } \
        if (w == 0) { gi0 = G[(size_t)(t0_ + lane) * 16 + h_]; gi1 = G[(size_t)(t0_ + 64 + lane) * 16 + h_]; gf0 = G[(size_t)(t0_ + lane) * 16 + 8 + h_]; gf1 = G[(size_t)(t0_ + 64 + lane) * 16 + 8 + h_]; } } while (0)
    if (F.bid < 2048) MA_LOAD(ml_unit(F.bid));
    for (int un = F.bid; un < 2048; un += F.G) {
        const int ci = ml_unit(un);
        const int bh = ci >> 6, c = ci & 63, h = bh & 7;
        __syncthreads();
        if (w == 0) {
            float ig0, ig1, lf0, lf1;
            { const float f = gf0 + gb[8 + h]; lf0 = fminf(f, 0.f) - log1pf(__expf(-fabsf(f))); ig0 = gi0 + gb[h]; }
            { const float f = gf1 + gb[8 + h]; lf1 = fminf(f, 0.f) - log1pf(__expf(-fabsf(f))); ig1 = gi1 + gb[h]; }
            float b0 = lf0, b1 = lf1;
#pragma unroll
            for (int o = 1; o < 64; o <<= 1) { const float u0 = __shfl_up(b0, o), u1 = __shfl_up(b1, o); if (lane >= o) { b0 += u0; b1 += u1; } }
            b1 += __shfl(b0, 63);
            const float a0 = ig0 - b0, a1 = ig1 - b1;
            float m0 = a0, m1 = a1;
#pragma unroll
            for (int o = 1; o < 64; o <<= 1) { const float u0 = __shfl_up(m0, o), u1 = __shfl_up(m1, o); if (lane >= o) { m0 = fmaxf(m0, u0); m1 = fmaxf(m1, u1); } }
            m1 = fmaxf(m1, __shfl(m0, 63));
            const float amax = __shfl(m1, 63), bl = __shfl(b1, 63);
            a_l[lane] = a0; a_l[64 + lane] = a1; w_l[lane] = 0.125f * __expf(a0 - amax); w_l[64 + lane] = 0.125f * __expf(a1 - amax);
            const size_t o = (size_t)bh * S + c * 128 + lane;
            AARR[o] = a0; AARR[o + 64] = a1; BARR[o] = b0; BARR[o + 64] = b1; CMARR[o] = m0; CMARR[o + 64] = m1;
            if (lane == 0) { AMAX[ci] = amax; BL[ci] = bl; }
        }
        __syncthreads();
        { const int s = tid & 127; const float ws = w_l[s];
#pragma unroll
          for (int i = 0; i < 2; ++i) { const int ch = (tid >> 7) + 4 * i; const v4u u = rk[i];
            const unsigned uu[4] = {u.x, u.y, u.z, u.w};
#pragma unroll
            for (int j = 0; j < 4; ++j) { const unsigned pr = pk2(bflo(uu[j]) * ws, bfhi(uu[j]) * ws);
                *(LAS unsigned short*)(KT + (8 * ch + 2 * j) * 272 + 2 * s) = (unsigned short)(pr & 0xffffu);
                *(LAS unsigned short*)(KT + (8 * ch + 2 * j + 1) * 272 + 2 * s) = (unsigned short)(pr >> 16); } } }
#pragma unroll
        for (int i = 0; i < 4; ++i) { const int cix = tid + 512 * i, e = cix >> 4, c16 = cix & 15; *(LAS v4u*)(VT + e * 272 + 16 * c16) = rv[i]; }
        if (un + F.G < 2048) MA_LOAD(ml_unit(un + F.G));
        __syncthreads();
        { const int eb = w & 3, db = w >> 2; f32x16 acc;
#pragma unroll
          for (int i = 0; i < 16; ++i) acc[i] = 0.f;
#pragma unroll
          for (int ks = 0; ks < 8; ++ks) { const bf16x8 av = *(const LAS bf16x8*)(VT + (32 * eb + r) * 272 + 32 * ks + 16 * hl);
              const bf16x8 bv = *(const LAS bf16x8*)(KT + (32 * db + r) * 272 + 32 * ks + 16 * hl); acc = MFMA32(av, bv, acc); }
          float* cp = CST + (size_t)ci * 8192;
#pragma unroll
          for (int i = 0; i < 16; ++i) cp[(32 * eb + crow(i, hl)) * 64 + 32 * db + r] = acc[i];
        }
        if (tid < 64) { float s = 0.f;
#pragma unroll
            for (int j = 0; j < 16; ++j) { const bf16x8 v = *(const LAS bf16x8*)(KT + tid * 272 + 16 * j);
#pragma unroll
                for (int q = 0; q < 8; ++q) s += bf2f(v[q]); }
            DN[(size_t)ci * 64 + tid] = s; }
    }
#undef MA_LOAD
}
DI void mlstm_b(Frame& F, const Args& a) {
    const float* AMAX = (const float*)(a.ws + WS_AMAX); const float* BL = (const float*)(a.ws + WS_BL); float* MPREV = (float*)(a.ws + WS_MPREV);
    const float* CST = (const float*)(a.ws + WS_CST); const float* DN = (const float*)(a.ws + WS_DN);
    unsigned* CIN = (unsigned*)(a.ws + WS_CIN); float* NIN = (float*)(a.ws + WS_NIN);
    for (int g = F.bid * NTHR + F.tid; g < 32 * 4096; g += F.G * NTHR) {
        const int bh = g >> 12, e2 = g & 4095;
        float c0 = 0.f, c1 = 0.f, m = 0.f, n0 = 0.f, n1 = 0.f;
#pragma unroll 1
        for (int cb = 0; cb < 64; cb += 16) {
            f32x2 d[16], dn[16]; float A[16], bl[16];
#pragma unroll
            for (int j = 0; j < 16; ++j) { const int ci = bh * 64 + cb + j; d[j] = *(const f32x2*)(CST + (size_t)ci * 8192 + 2 * e2); A[j] = AMAX[ci]; bl[j] = BL[ci];
                dn[j] = (e2 < 32) ? *(const f32x2*)(DN + (size_t)ci * 64 + 2 * e2) : (f32x2){0.f, 0.f}; }
#pragma unroll
            for (int j = 0; j < 16; ++j) { const int ci = bh * 64 + cb + j;
                CIN[(size_t)ci * 4096 + e2] = pk2(c0, c1);
                if (e2 < 32) { NIN[(size_t)ci * 64 + 2 * e2] = n0; NIN[(size_t)ci * 64 + 2 * e2 + 1] = n1; }
                if (e2 == 0) MPREV[ci] = m;
                const float M = fmaxf(m, A[j]), dec = __expf(m - M), sc = __expf(A[j] - M);
                c0 = dec * c0 + sc * d[j].x; c1 = dec * c1 + sc * d[j].y;
                n0 = dec * n0 + sc * dn[j].x; n1 = dec * n1 + sc * dn[j].y;
                m = bl[j] + M; }
        }
    }
}
DI void mlstm_c(Frame& F, const Args& a) {
    LAS unsigned char* lds = F.lds;
    LAS float* a_l = (LAS float*)lds;
    LAS float* n_l = (LAS float*)(lds + 512);
    LAS float* ssq = (LAS float*)(lds + 1024);
    LAS unsigned char* Qt = lds + 2048;
    LAS unsigned char* Kt = Qt + 128 * 144;
    LAS unsigned char* CT = Kt + 128 * 144;
    LAS unsigned char* VT = CT + 128 * 144;
    LAS unsigned char* OG = VT + 128 * 264;
    LAS float* HG = (LAS float*)(OG + 128 * 272);
    const bf16* P = (const bf16*)(a.ws + WS_P); const bf16* VTA = (const bf16*)(a.ws + WS_VTA);
    const float* AARR = (const float*)(a.ws + WS_AARR); const float* BARR = (const float*)(a.ws + WS_BARR); const float* CMARR = (const float*)(a.ws + WS_CMARR);
    const float* MPREV = (const float*)(a.ws + WS_MPREV); const bf16* CIN = (const bf16*)(a.ws + WS_CIN); const float* NIN = (const float*)(a.ws + WS_NIN);
    bf16* HM = (bf16*)(a.ws + WS_H); const float* hg = a.in[8];
    const int tid = F.tid, lane = F.lane, w = F.wave, r = lane & 31, hl = lane >> 5;
    for (int i = F.tid; i < 1024; i += NTHR) HG[i] = hg[i];
    const int tbw = (w < 4) ? w : 7 - w;
    v4u rq[2], rkk[2], rc[2], rvv[4], rog[4]; float rsm = 0.f, rmp = 0.f, rcm = 0.f, rbt = 0.f;
#define MC_LOAD(ci_) do { const int bh_ = (ci_) >> 6, c_ = (ci_) & 63, b_ = bh_ >> 3, h_ = bh_ & 7, t0_ = b_ * S + c_ * 128; \
        _Pragma("unroll") for (int i = 0; i < 2; ++i) { const int cix = tid + 512 * i, row = cix >> 3, c8 = cix & 7; \
            rq[i] = *(const v4u*)(P + (size_t)(t0_ + row) * 2048 + h_ * 64 + 8 * c8); rkk[i] = *(const v4u*)(P + (size_t)(t0_ + row) * 2048 + 512 + h_ * 64 + 8 * c8); \
            rc[i] = *(const v4u*)(CIN + (size_t)(ci_) * 8192 + row * 64 + 8 * c8); } \
        _Pragma("unroll") for (int i = 0; i < 4; ++i) { const int cix = tid + 512 * i; rvv[i] = *(const v4u*)(VTA + (size_t)(h_ * 128 + (cix >> 4)) * T + t0_ + 8 * (cix & 15)); } \
        _Pragma("unroll") for (int i = 0; i < 4; ++i) { const int cix = tid + 512 * i; rog[i] = *(const v4u*)(P + (size_t)(t0_ + (cix >> 4)) * 2048 + 1024 + h_ * 128 + 8 * (cix & 15)); } \
        if (tid < 128) rsm = AARR[(size_t)bh_ * S + c_ * 128 + tid]; else if (tid < 192) rsm = NIN[(size_t)(ci_) * 64 + tid - 128]; \
        rmp = MPREV[(ci_)]; rcm = CMARR[(size_t)bh_ * S + c_ * 128 + 32 * tbw + r]; rbt = BARR[(size_t)bh_ * S + c_ * 128 + 32 * tbw + r]; } while (0)
    if (F.bid < 2048) MC_LOAD(ml_unit(F.bid));
    for (int un = F.bid; un < 2048; un += F.G) {
        const int ci = ml_unit(un);
        const int bh = ci >> 6, c = ci & 63, b = bh >> 3, h = bh & 7, t0 = b * S + c * 128;
        __syncthreads();
        if (tid < 128) a_l[tid] = rsm;
        else if (tid < 192) n_l[tid - 128] = rsm;
#pragma unroll
        for (int i = 0; i < 2; ++i) { const int cix = tid + 512 * i, row = cix >> 3, c8 = cix & 7;
            *(LAS v4u*)(Qt + row * 144 + 16 * c8) = rq[i]; *(LAS v4u*)(Kt + row * 144 + 16 * c8) = rkk[i]; *(LAS v4u*)(CT + row * 144 + 16 * c8) = rc[i]; }
#pragma unroll
        for (int i = 0; i < 4; ++i) { const int cix = tid + 512 * i, e = cix >> 4, c16 = cix & 15; const v4u u = rvv[i];
            *(LAS v2u*)(VT + e * 264 + 16 * c16) = (v2u){u.x, u.y}; *(LAS v2u*)(VT + e * 264 + 16 * c16 + 8) = (v2u){u.z, u.w};
            *(LAS v4u*)(OG + e * 272 + 16 * c16) = rog[i]; }
        __syncthreads();
        const float mprev = rmp, cm_t = rcm, bt = rbt;
        if (un + F.G < 2048) MC_LOAD(ml_unit(un + F.G));
        const int tb = tbw, eh = w >> 2, tl = 32 * tb + r;
        bf16x8 qf[4];
#pragma unroll
        for (int kk = 0; kk < 4; ++kk) qf[kk] = *(const LAS bf16x8*)(Qt + tl * 144 + 32 * kk + 16 * hl);
        f32x16 acc[2];
#pragma unroll
        for (int eb = 0; eb < 2; ++eb) {
#pragma unroll
            for (int i = 0; i < 16; ++i) acc[eb][i] = 0.f;
#pragma unroll
            for (int kk = 0; kk < 4; ++kk) { const bf16x8 cv = *(const LAS bf16x8*)(CT + (64 * eh + 32 * eb + r) * 144 + 32 * kk + 16 * hl); acc[eb] = MFMA32(cv, qf[kk], acc[eb]); } }
        float qn = 0.f;
#pragma unroll
        for (int kk = 0; kk < 4; ++kk)
#pragma unroll
            for (int j = 0; j < 8; ++j) qn += bf2f(qf[kk][j]) * n_l[16 * kk + 8 * hl + j];
        qn += __shfl_xor(qn, 32);
        const float Mt = fmaxf(mprev, cm_t);
        const float winter = __expf(mprev - Mt);
#pragma unroll
        for (int eb = 0; eb < 2; ++eb)
#pragma unroll
            for (int i = 0; i < 16; ++i) acc[eb][i] *= winter;
        float den = 0.f;
        for (int sb = 0; sb <= tb; ++sb) {
            f32x16 st;
#pragma unroll
            for (int i = 0; i < 16; ++i) st[i] = 0.f;
#pragma unroll
            for (int kk = 0; kk < 4; ++kk) { const bf16x8 kv = *(const LAS bf16x8*)(Kt + (32 * sb + r) * 144 + 32 * kk + 16 * hl); st = MFMA32(kv, qf[kk], st); }
#pragma unroll
            for (int g = 0; g < 4; ++g) { const f32x4 av = *(const LAS f32x4*)(a_l + 32 * sb + 8 * g + 4 * hl);
#pragma unroll
                for (int j = 0; j < 4; ++j) { const int i = 4 * g + j, s = 32 * sb + 8 * g + 4 * hl + j; const float e = __builtin_amdgcn_exp2f((av[j] - Mt) * 1.4426950408889634f);
                    const float p = (s <= tl) ? st[i] * 0.125f * e : 0.f; den += p; st[i] = p; } }
#pragma unroll
            for (int ks = 0; ks < 2; ++ks) { const bf16x8 pf = pack8(st[8 * ks], st[8 * ks + 1], st[8 * ks + 2], st[8 * ks + 3], st[8 * ks + 4], st[8 * ks + 5], st[8 * ks + 6], st[8 * ks + 7]);
#pragma unroll
                for (int eb = 0; eb < 2; ++eb) { const LAS unsigned char* vp = VT + (64 * eh + 32 * eb + r) * 264 + (32 * sb + 16 * ks + 4 * hl) * 2;
                    const s16x4 lo = *(const LAS s16x4*)vp, hi = *(const LAS s16x4*)(vp + 16);
                    const bf16x8 vf = __builtin_shufflevector(lo, hi, 0, 1, 2, 3, 4, 5, 6, 7); acc[eb] = MFMA32(vf, pf, acc[eb]); } }
        }
        den += __shfl_xor(den, 32);
        const float dtot = winter * qn + den;
        const float dinv = __builtin_amdgcn_rcpf(fmaxf(fabsf(dtot), __expf(-(bt + Mt))));
        float sq = 0.f;
#pragma unroll
        for (int eb = 0; eb < 2; ++eb)
#pragma unroll
            for (int i = 0; i < 16; ++i) { acc[eb][i] *= dinv; sq += acc[eb][i] * acc[eb][i]; }
        sq += __shfl_xor(sq, 32);
        if (hl == 0) ssq[eh * 128 + tl] = sq;
        __syncthreads();
        const float rinv = rsqrtf((ssq[tl] + ssq[128 + tl]) * (1.f / 128.f) + EPS);
#pragma unroll
        for (int eb = 0; eb < 2; ++eb)
#pragma unroll
            for (int g = 0; g < 4; ++g) { const int e = 64 * eh + 32 * eb + 8 * g + 4 * hl;
                const v2u ou = *(const LAS v2u*)(OG + tl * 272 + 2 * e); const f32x4 gg = *(const LAS f32x4*)(HG + h * 128 + e);
                const float o0 = bflo(ou.x), o1 = bfhi(ou.x), o2 = bflo(ou.y), o3 = bfhi(ou.y);
                const float y0 = acc[eb][4 * g] * rinv * gg.x * __builtin_amdgcn_rcpf(1.f + __expf(-o0)), y1 = acc[eb][4 * g + 1] * rinv * gg.y * __builtin_amdgcn_rcpf(1.f + __expf(-o1));
                const float y2 = acc[eb][4 * g + 2] * rinv * gg.z * __builtin_amdgcn_rcpf(1.f + __expf(-o2)), y3 = acc[eb][4 * g + 3] * rinv * gg.w * __builtin_amdgcn_rcpf(1.f + __expf(-o3));
                v2u wv; wv.x = pk2(y0, y1); wv.y = pk2(y2, y3); *(LAS v2u*)(Qt + tl * 272 + 2 * e) = wv; }
        __syncthreads();
#pragma unroll
        for (int i = 0; i < 4; ++i) { const int cix = tid + 512 * i, row = cix >> 4, c16 = cix & 15;
            *(v4u*)(HM + (size_t)(t0 + row) * 1024 + h * 128 + 8 * c16) = *(const LAS v4u*)(Qt + row * 272 + 16 * c16); }
    }
#undef MC_LOAD
}

constexpr int AT_KROW = 400, AT_VROW = 144, AT_KSLOT = 64 * AT_KROW, AT_VSLOT = 128 * AT_VROW, AT_VBASE = 2 * AT_KSLOT;
static_assert(AT_VBASE + 3 * AT_VSLOT <= 131072, "attention LDS rings");
#define AT_FENCE() __builtin_amdgcn_sched_barrier(0)
DI void at_qk(const LAS unsigned char* kp, const bf16x8 (&qf)[12], f32x16& st) {
    bf16x8 kf[5];
#pragma unroll
    for (int j = 0; j < 5; ++j) kf[j] = *(const LAS bf16x8*)(kp + 32 * j);
    AT_FENCE();
#pragma unroll
    for (int i = 0; i < 16; ++i) st[i] = 0.f;
#pragma unroll
    for (int kk = 0; kk < 12; ++kk) { st = MFMA32(kf[kk % 5], qf[kk], st); if (kk + 5 < 12) { kf[kk % 5] = *(const LAS bf16x8*)(kp + 32 * (kk + 5)); AT_FENCE(); } }
}
DI void at_block(const LAS unsigned char* kp, const LAS unsigned char* vp, const bool diag, const int dd, const bf16x8 (&qf)[12],
                 float& m_run, float& l_run, f32x16 (&acc)[4], bf16x8& pf0, bf16x8& pf1, const LAS unsigned char*& vprev) {
    constexpr float SCL = 0.07216878364870322f * 1.4426950408889634f;
    bf16x8 vf[4];
    f32x16 st;
    at_qk(kp, qf, st);
#pragma unroll
    for (int eb = 0; eb < 4; ++eb) vf[eb] = *(const LAS bf16x8*)(vprev + 32 * eb * AT_VROW);
    if (diag) {
        asm volatile("" ::: "memory");
#pragma unroll
        for (int i = 0; i < 16; ++i) { const int cr = (i & 3) + 8 * (i >> 2); if (cr > dd) st[i] = -1e30f; }
    }
    float mx = fmaxf(st[0], st[1]);
#pragma unroll
    for (int i = 2; i < 16; ++i) mx = fmaxf(mx, st[i]);
    constexpr float AT_THR = 8.0f;
    const float mc = mx * SCL;
    const bool resc = __builtin_amdgcn_ballot_w64(mc > m_run + AT_THR) != 0ull;
    float alpha = 1.0f;
    if (resc) { const float mfull = fmaxf(mc, __shfl_xor(mc, 32));
                const float m_new = fmaxf(m_run, mfull);
                alpha = __builtin_amdgcn_exp2f(m_run - m_new); l_run *= alpha; m_run = m_new; }
    const float nm = -m_run;
#define AT_EXP(i_) do { const float p_ = __builtin_amdgcn_exp2f(__builtin_fmaf(st[(i_)], SCL, nm)); l_run += p_; st[(i_)] = p_; } while (0)
    AT_FENCE();
#pragma unroll
    for (int eb = 0; eb < 4; ++eb) { acc[eb] = MFMA32(vf[eb], pf0, acc[eb]); vf[eb] = *(const LAS bf16x8*)(vprev + 32 * eb * AT_VROW + 32); AT_EXP(2 * eb); AT_EXP(2 * eb + 1); AT_FENCE(); }
#pragma unroll
    for (int eb = 0; eb < 4; ++eb) { acc[eb] = MFMA32(vf[eb], pf1, acc[eb]); AT_EXP(8 + 2 * eb); AT_EXP(9 + 2 * eb); AT_FENCE(); }
#undef AT_EXP
    if (resc) {
        asm volatile("" ::: "memory");
#pragma unroll
        for (int eb = 0; eb < 4; ++eb)
#pragma unroll
            for (int i = 0; i < 16; ++i) acc[eb][i] *= alpha;
    }
    pf0 = pack8(st[0], st[1], st[2], st[3], st[4], st[5], st[6], st[7]);
    pf1 = pack8(st[8], st[9], st[10], st[11], st[12], st[13], st[14], st[15]);
    vprev = vp;
}
DI void attn_unit(Frame& F, const Args& a, int b, int h, int qb) {
    LAS unsigned char* lds = F.lds;
    const bf16* Q = (const bf16*)(a.ws + WS_Q); const bf16* KN = (const bf16*)(a.ws + WS_KN); const bf16* KR = (const bf16*)(a.ws + WS_KR); const bf16* VTB = (const bf16*)(a.ws + WS_VTB);
    const float* COS = (const float*)(a.ws + WS_COS); const float* SIN = (const float*)(a.ws + WS_SIN); bf16* O = (bf16*)(a.ws + WS_O);
    int tid_ = F.tid; asm volatile("" : "+v"(tid_));
    const int tid = tid_, lane = tid & 63, w = F.wave, r = lane & 31, hl = lane >> 5;
    const int q0 = qb * 256, qpos = q0 + 32 * w + r, tq = b * S + qpos;
    bf16x8 qf[12];
    { const bf16* qrow = Q + (size_t)tq * 1536 + h * 192 + 8 * hl;
#pragma unroll
      for (int kk = 0; kk < 8; ++kk) qf[kk] = *(const bf16x8*)(qrow + 16 * kk);
#pragma unroll
      for (int p = 0; p < 2; ++p) { const bf16x8 x1 = *(const bf16x8*)(qrow + 128 + 16 * p), x2 = *(const bf16x8*)(qrow + 160 + 16 * p);
        const float* cp = COS + (size_t)tq * 32 + 16 * p + 8 * hl; const float* sp = SIN + (size_t)tq * 32 + 16 * p + 8 * hl;
        const f32x4 c0 = *(const f32x4*)cp, c1 = *(const f32x4*)(cp + 4), s0 = *(const f32x4*)sp, s1 = *(const f32x4*)(sp + 4);
        float o1[8], o2[8];
#pragma unroll
        for (int j = 0; j < 8; ++j) { const float u1 = bf2f(x1[j]), u2 = bf2f(x2[j]); const float cc = j < 4 ? c0[j & 3] : c1[j & 3], sn = j < 4 ? s0[j & 3] : s1[j & 3];
            o1[j] = u1 * cc - u2 * sn; o2[j] = u2 * cc + u1 * sn; }
        qf[8 + p] = pack8(o1[0], o1[1], o1[2], o1[3], o1[4], o1[5], o1[6], o1[7]); qf[10 + p] = pack8(o2[0], o2[1], o2[2], o2[3], o2[4], o2[5], o2[6], o2[7]); } }
    f32x16 acc[4];
#pragma unroll
    for (int eb = 0; eb < 4; ++eb)
#pragma unroll
        for (int i = 0; i < 16; ++i) acc[eb][i] = 0.f;
    float m_run = -1e30f, l_run = 0.f;
    const int nt = (qb + 1) * 4;
    const unsigned kn_off = (unsigned)((b * S + (tid >> 4)) * 1024 + h * 128 + 8 * (tid & 15));
    const unsigned kr_off = (unsigned)((b * S + (tid >> 3)) * 64 + 8 * (tid & 7));
    const unsigned vt_off = (unsigned)((h * 128 + (tid >> 3)) * T + b * S + 8 * (tid & 7));
    const int kn_dst = (tid >> 4) * AT_KROW + 16 * (tid & 15), kr_dst = (tid >> 3) * AT_KROW + 256 + 16 * (tid & 7);
    const int vt_dst = AT_VBASE + (tid >> 3) * AT_VROW + 32 * ((tid & 7) >> 1) + 8 * (tid & 1);
    v4u rk0, rk1, rr, rv0, rv1;
#define AT_LOADK(key0) do { rk0 = *(const v4u*)(KN + (kn_off + (unsigned)(key0) * 1024u)); rk1 = *(const v4u*)(KN + (kn_off + (unsigned)((key0) + 32) * 1024u)); rr = *(const v4u*)(KR + (kr_off + (unsigned)(key0) * 64u)); } while (0)
#define AT_LOADV(key0) do { rv0 = *(const v4u*)(VTB + (vt_off + (unsigned)(key0))); rv1 = *(const v4u*)(VTB + (vt_off + 64u * (unsigned)T + (unsigned)(key0))); } while (0)
#define AT_STOREK(ks_) do { LAS unsigned char* kb_ = lds + (ks_) * AT_KSLOT; *(LAS v4u*)(kb_ + kn_dst) = rk0; *(LAS v4u*)(kb_ + kn_dst + 32 * AT_KROW) = rk1; *(LAS v4u*)(kb_ + kr_dst) = rr; } while (0)
#define AT_STOREV(vs_) do { LAS unsigned char* vb_ = lds + (vs_) * AT_VSLOT; *(LAS v2u*)(vb_ + vt_dst) = (v2u){rv0.x, rv0.y}; *(LAS v2u*)(vb_ + vt_dst + 16) = (v2u){rv0.z, rv0.w}; \
        *(LAS v2u*)(vb_ + vt_dst + 64 * AT_VROW) = (v2u){rv1.x, rv1.y}; *(LAS v2u*)(vb_ + vt_dst + 64 * AT_VROW + 16) = (v2u){rv1.z, rv1.w}; } while (0)
    AT_LOADK(0); AT_LOADV(0); AT_STOREK(0); AT_STOREV(0);
    __syncthreads();
    const int koff = r * AT_KROW + 16 * hl, voff = AT_VBASE + r * AT_VROW + 16 * hl;
    bf16x8 pf0, pf1; const LAS unsigned char* vprev = lds + voff;
#pragma unroll
    for (int j = 0; j < 8; ++j) { pf0[j] = 0; pf1[j] = 0; }
    int vs = 0;
    for (int kt = 0; kt < nt; ++kt) {
        const int key0 = kt * 64;
        const int vsn = (vs == 2) ? 0 : vs + 1;
        if (kt + 1 < nt) AT_LOADK(key0 + 64);
        const LAS unsigned char* Kc = lds + (kt & 1) * AT_KSLOT + koff; const LAS unsigned char* Vc = lds + vs * AT_VSLOT + voff;
        const bool diag = (key0 + 63 > q0 + 32 * w);
        const int dd = qpos - key0 - 4 * hl;
        at_block(Kc, Vc, diag, dd, qf, m_run, l_run, acc, pf0, pf1, vprev);
        if (kt + 1 < nt) { AT_STOREK((kt + 1) & 1); AT_LOADV(key0 + 64); }
        at_block(Kc + 32 * AT_KROW, Vc + 64, diag, dd - 32, qf, m_run, l_run, acc, pf0, pf1, vprev);
        if (kt + 1 < nt) AT_STOREV(vsn);
        __syncthreads();
        vs = vsn;
    }
#undef AT_LOADK
#undef AT_LOADV
#undef AT_STOREK
#undef AT_STOREV
    {
        bf16x8 vf[4];
#pragma unroll
        for (int eb = 0; eb < 4; ++eb) vf[eb] = *(const LAS bf16x8*)(vprev + 32 * eb * AT_VROW);
#pragma unroll
        for (int eb = 0; eb < 4; ++eb) { acc[eb] = MFMA32(vf[eb], pf0, acc[eb]); vf[eb] = *(const LAS bf16x8*)(vprev + 32 * eb * AT_VROW + 32); }
#pragma unroll
        for (int eb = 0; eb < 4; ++eb) acc[eb] = MFMA32(vf[eb], pf1, acc[eb]);
    }
    const float linv = 1.f / (l_run + __shfl_xor(l_run, 32));
    int tid2 = F.tid; asm volatile("" : "+v"(tid2));
    const int r2 = tid2 & 31, hl2 = (tid2 >> 5) & 1;
    bf16* orow = (bf16*)(a.ws + WS_O) + (size_t)(b * S + qb * 256 + 32 * w + r2) * 1024 + h * 128;
#pragma unroll
    for (int eb = 0; eb < 4; ++eb)
#pragma unroll
        for (int g = 0; g < 4; ++g) { v2u wv; wv.x = pk2(acc[eb][4 * g] * linv, acc[eb][4 * g + 1] * linv); wv.y = pk2(acc[eb][4 * g + 2] * linv, acc[eb][4 * g + 3] * linv);
            *(v2u*)(orow + 32 * eb + 8 * g + 4 * hl2) = wv; }
    __syncthreads();
}
DI void attn_phase(Frame& F, const Args& a) {
    for (int wg = F.bid; wg < 256; wg += F.G) {
        const int bh = wg & 31, g = wg >> 5, b = bh >> 3, h = bh & 7;
#pragma unroll 1
        for (int i = 0; i < 4; ++i) { const int qb = (i == 0) ? 31 - g : (i == 1) ? 23 - g : (i == 2) ? 8 + g : g; attn_unit(F, a, b, h, qb); }
    }
}

template <class Epi> DI void run_gemm(Frame& F, const bf16* A, const bf16* Bt, int M, int N, int K, const Epi& E) {
    pg8::Gemm g{A, Bt, M, N, K}; pg8::StaticOrder So; So.init(M, N, F.G, F.bid);
    pg8::gemm_phase<Epi, pg8::StaticOrder, PG8_ALIGN, PG8_SP2>((PG8_LAS unsigned char*)F.lds, g, So, E);
}

__global__ void __launch_bounds__(NTHR, 2) yoco_fwd(Args args) {
    extern __shared__ __attribute__((aligned(16))) unsigned char lds_raw[];
    Frame F; F.lds = (LAS unsigned char*)lds_raw; F.tid = threadIdx.x; F.lane = F.tid & 63; F.wave = __builtin_amdgcn_readfirstlane(F.tid >> 6); F.G = gridDim.x; F.bid = blockIdx.x;
    unsigned char* ws = args.ws;
    const int lo = args.ph_lo, hi = args.ph_hi;
#define REFRESH() do { int t_ = threadIdx.x; asm volatile("" : "+v"(t_)); F.tid = t_; F.lane = t_ & 63; } while (0)
    volatile LAS unsigned* MISC = (volatile LAS unsigned*)(F.lds + MISC_OFF);
    if (F.tid < 32) MISC[F.tid] = 0u;
    __syncthreads();
    XcdBarrier bar = xcd_barrier_post((unsigned*)ws + CW_BAR, MISC + 8);
#define IN(k) (lo <= (k) && (k) < hi)
#if MK_MULTI
#define SEAM(k) do { } while (0)
#else
#define SEAM(k) do { if (IN(k) && IN((k) + 1)) { if ((k) == 0) cg::this_grid().sync(); else xcd_barrier(bar); } } while (0)
#endif
    const float* ADA0 = (const float*)(ws + WS_ADA); const float* ADA1 = ADA0 + 4 * 6144; const float* KVADA = ADA0 + 8 * 6144;
    const float* norm_g = args.in[5];
    bf16* H = (bf16*)(ws + WS_H); bf16* H2 = (bf16*)(ws + WS_H2); bf16* Y = (bf16*)(ws + WS_Y); bf16* U = (bf16*)(ws + WS_U);
    void* X = (void*)args.out;
    void* X3 = (void*)(ws + WS_H2);

    REFRESH();
    if (IN(0)) { p0_weights(F, args); p0_ada(F, args); p0_rope(F, args); }
    SEAM(0);
    REFRESH();
    if (IN(1)) row_phase<false, 1, false, false>(F, args.in[0], nullptr, nullptr, nullptr, nullptr, 0, norm_g + 0 * D, ADA0 + 0, ADA0 + 1024, 6144, H, nullptr, nullptr, nullptr, 0, nullptr);
    SEAM(1);
    REFRESH();
    if (IN(2)) {
        pg8::EpiProj E{(bf16*)(ws + WS_P), 2048, (float*)(ws + WS_G), 8};
        run_gemm(F, H, (const bf16*)(ws + W_IN), T, 2304, 1024, E);
        pg8::EpiOut<0> E2{(bf16*)(ws + WS_VTA), T};
        run_gemm(F, (const bf16*)(ws + W_V), H, 1024, T, 1024, E2);
    }
    SEAM(2);
    REFRESH();
    if (IN(3)) mlstm_a(F, args);
    SEAM(3);
    REFRESH();
    if (IN(4)) mlstm_b(F, args);
    SEAM(4);
    REFRESH();
    if (IN(5)) mlstm_c(F, args);
    SEAM(5);
    REFRESH();
    if (IN(6)) { pg8::EpiOut<0> E{Y, 1024}; run_gemm(F, H, (const bf16*)(ws + W_AO), T, 1024, 1024, E); }
    SEAM(6);
    REFRESH();
    if (IN(7)) row_phase<true, 1, false, true>(F, args.in[0], X, Y, norm_g + 1 * D, ADA0 + 2048, 6144, norm_g + 2 * D, ADA0 + 3072, ADA0 + 4096, 6144, H, nullptr, nullptr, nullptr, 0, nullptr);
    SEAM(7);
    REFRESH();
    if (IN(8)) { pg8::EpiOut<2> E{U, FF}; run_gemm(F, H, (const bf16*)(ws + W_1A), T, FF, 1024, E); }
    SEAM(8);
    REFRESH();
    if (IN(9)) { pg8::EpiOut<0> E{Y, 1024}; run_gemm(F, U, (const bf16*)(ws + W_2A), T, 1024, FF, E); }
    SEAM(9);
    REFRESH();
    if (IN(10)) row_phase<true, 2, true, true>(F, X, X, Y, norm_g + 3 * D, ADA0 + 5120, 6144, args.in[12], KVADA + 0, KVADA + 1024, 2048, H, norm_g + 4 * D, ADA1 + 0, ADA1 + 1024, 6144, H2);
    SEAM(10);
    REFRESH();
    if (IN(11)) {
        pg8::EpiOut<0> E{(bf16*)(ws + WS_KVA), 512}; run_gemm(F, H, (const bf16*)(ws + W_KVA), T, 512, 1024, E);
        pg8::EpiOut<0> E2{(bf16*)(ws + WS_QA), 512}; run_gemm(F, H2, (const bf16*)(ws + W_QA), T, 512, 1024, E2);
    }
    SEAM(11);
    REFRESH();
    if (IN(12)) latent_phase(F, args);
    SEAM(12);
    REFRESH();
    if (IN(13)) {
        pg8::EpiOut<0> E{(bf16*)(ws + WS_KN), 1024}; run_gemm(F, (const bf16*)(ws + WS_CKV), (const bf16*)(ws + W_BK), T, 1024, 256, E);
        pg8::EpiOut<0> E2{(bf16*)(ws + WS_VTB), T}; run_gemm(F, (const bf16*)(ws + W_BV), (const bf16*)(ws + WS_CKV), 1024, T, 256, E2);
        pg8::EpiOut<0> E3{(bf16*)(ws + WS_Q), 1536}; run_gemm(F, (const bf16*)(ws + WS_CQ), (const bf16*)(ws + W_QB), T, 1536, 384, E3);
    }
    SEAM(13);
    REFRESH();
    if (IN(14)) attn_phase(F, args);
    SEAM(14);
    REFRESH();
    if (IN(15)) { pg8::EpiOut<0> E{Y, 1024}; run_gemm(F, (const bf16*)(ws + WS_O), (const bf16*)(ws + W_BO), T, 1024, 1024, E); }
    SEAM(15);
    REFRESH();
    if (IN(16)) row_phase<true, 1, true, true>(F, X, X3, Y, norm_g + 5 * D, ADA1 + 2048, 6144, norm_g + 6 * D, ADA1 + 3072, ADA1 + 4096, 6144, H, nullptr, nullptr, nullptr, 0, nullptr);
    SEAM(16);
    REFRESH();
    if (IN(17)) { pg8::EpiOut<2> E{U, FF}; run_gemm(F, H, (const bf16*)(ws + W_1B), T, FF, 1024, E); }
    SEAM(17);
    REFRESH();
    if (IN(18)) { pg8::EpiOut<0> E{Y, 1024}; run_gemm(F, U, (const bf16*)(ws + W_2B), T, 1024, FF, E); }
    SEAM(18);
    REFRESH();
    if (IN(19)) row_phase<true, 0, true, false>(F, X3, args.out, Y, norm_g + 7 * D, ADA1 + 5120, 6144, nullptr, nullptr, nullptr, 0, nullptr, nullptr, nullptr, nullptr, 0, nullptr);
#undef IN
#undef SEAM
#undef REFRESH
}

extern "C" void kernel_launch(void* const* d_in, const int* in_sizes, int n_in, void* d_out, int out_size, void* d_ws, size_t ws_size, hipStream_t stream) {
    static int grid = 0;
    if (grid == 0) {
        if (n_in != 22 || in_sizes[0] != T * D || out_size != T * D || ws_size < WS_END) { fprintf(stderr, "kernel_launch: unexpected shapes (n_in %d, in0 %d, out %d, ws %zu)\n", n_in, n_in > 0 ? in_sizes[0] : -1, out_size, ws_size); grid = -1; return; }
        int dev = 0, cus = 0, per_cu = 0;
        (void)hipGetDevice(&dev); (void)hipDeviceGetAttribute(&cus, hipDeviceAttributeMultiprocessorCount, dev);
        if (hipFuncSetAttribute((const void*)yoco_fwd, hipFuncAttributeMaxDynamicSharedMemorySize, LDS_BYTES) != hipSuccess) { fprintf(stderr, "kernel_launch: hipFuncSetAttribute failed\n"); grid = -1; return; }
        if (hipOccupancyMaxActiveBlocksPerMultiprocessor(&per_cu, (const void*)yoco_fwd, NTHR, LDS_BYTES) != hipSuccess || per_cu < 1) { fprintf(stderr, "kernel_launch: occupancy query says %d\n", per_cu); per_cu = 1; }
        (void)hipGetLastError();
        grid = cus;
        if (grid > 256) grid = 256;
    }
    if (grid < 0) return;
    Args a; memset(&a, 0, sizeof(a));
    for (int i = 0; i < 22; ++i) a.in[i] = (const float*)d_in[i];
    a.out = (float*)d_out; a.ws = (unsigned char*)d_ws;
    for (int i = 0; i < 32; ++i) a.inv_freq[i] = powf(10000.0f, -(float)i / 32.0f);
#if MK_MULTI
    for (int p = 0; p < NPHASE; ++p) { a.ph_lo = p; a.ph_hi = p + 1; hipLaunchKernelGGL(yoco_fwd, dim3(grid), dim3(NTHR), LDS_BYTES, stream, a); }
#else
    a.ph_lo = 0; a.ph_hi = NPHASE;
    if (hipMemsetAsync(d_ws, 0, CTL_ZERO_BYTES, stream) != hipSuccess) { fprintf(stderr, "kernel_launch: memset failed\n"); return; }
    void* kargs[] = {&a};
    hipError_t e = hipLaunchCooperativeKernel((const void*)yoco_fwd, dim3(grid), dim3(NTHR), kargs, LDS_BYTES, stream);
    if (e != hipSuccess) fprintf(stderr, "kernel_launch: cooperative launch failed: %s (grid %d)\n", hipGetErrorString(e), grid);
#endif
}
```
